# Optimizing an MI355X kernel written in HIP

```python
import jax, jax.numpy as jnp
from jax import lax
import numpy as np

D_MODEL = 1024
BATCH = 2
SEQ = 16384
DEPTH = 1

MLA_HEADS = 8
QK_NOPE_DIM = 64
QK_ROPE_DIM = 32
QK_DIM = QK_NOPE_DIM + QK_ROPE_DIM
V_HEAD_DIM = 64
MLA_WIDTH = MLA_HEADS * V_HEAD_DIM
Q_LORA_RANK = 256
KV_LORA_RANK = 128
ROPE_THETA = 10000.0
Q_BLOCK = 128
SGU_GROUPS = 8
SGU_GROUP_DIM = 64
SGU_WIDTH = SGU_GROUPS * SGU_GROUP_DIM
SGU_CHUNK = 128
N_GROUPS = 4
EXPERTS_PER_GROUP = 8
N_EXPERTS = N_GROUPS * EXPERTS_PER_GROUP
TOP_K = 2
EXPERT_FF = 512
MOE_BLOCK = 256
N_BRANCHES = 2
N_MOD = 6
EPS = 1e-6
IN_WIDTH = Q_LORA_RANK + KV_LORA_RANK + QK_ROPE_DIM + 2 * SGU_WIDTH + N_BRANCHES * D_MODEL

kernel_name = "hybrid_mla_sgu_hmoe_adaln_block"


def rmsnorm(x, g):
    xf = x.astype(jnp.float32)
    y = xf * lax.rsqrt(jnp.mean(xf * xf, axis=-1, keepdims=True) + EPS)
    return (y * g.astype(jnp.float32)).astype(x.dtype)


def layernorm(x, g, b):
    xf = x.astype(jnp.float32)
    mu = jnp.mean(xf, axis=-1, keepdims=True)
    var = jnp.mean(jnp.square(xf - mu), axis=-1, keepdims=True)
    y = (xf - mu) * lax.rsqrt(var + EPS)
    return (y * g.astype(jnp.float32) + b.astype(jnp.float32)).astype(x.dtype)


def rope(x, positions):
    half = x.shape[-1] // 2
    freqs = ROPE_THETA ** (-jnp.arange(half, dtype=jnp.float32) / half)
    ang = positions.astype(jnp.float32)[..., None] * freqs
    cos = jnp.cos(ang)[:, :, None, :]
    sin = jnp.sin(ang)[:, :, None, :]
    xf = x.astype(jnp.float32)
    x1, x2 = xf[..., :half], xf[..., half:]
    out = jnp.concatenate([x1 * cos - x2 * sin, x1 * sin + x2 * cos], axis=-1)
    return out.astype(x.dtype)


def mla(c_q, c_kv, k_rope, positions, q_norm_g, w_uq, kv_norm_g, w_ukv):
    B, S, _ = c_q.shape
    q = (rmsnorm(c_q, q_norm_g) @ w_uq).reshape(B, S, MLA_HEADS, QK_DIM)
    q = jnp.concatenate([q[..., :QK_NOPE_DIM], rope(q[..., QK_NOPE_DIM:], positions)], axis=-1)
    kv = (rmsnorm(c_kv, kv_norm_g) @ w_ukv).reshape(B, S, MLA_HEADS, QK_NOPE_DIM + V_HEAD_DIM)
    k_nope, v = kv[..., :QK_NOPE_DIM], kv[..., QK_NOPE_DIM:]
    k_pe = rope(k_rope[:, :, None, :], positions)
    k = jnp.concatenate([k_nope, jnp.broadcast_to(k_pe, (B, S, MLA_HEADS, QK_ROPE_DIM))], axis=-1)
    scale = QK_DIM ** -0.5
    nb = S // Q_BLOCK
    qb = q.reshape(B, nb, Q_BLOCK, MLA_HEADS, QK_DIM).transpose(1, 0, 2, 3, 4)
    k_idx = jnp.arange(S)

    def attend_block(args):
        q_blk, i = args
        s = jnp.einsum('bqhd,bkhd->bhqk', q_blk, k).astype(jnp.float32) * scale
        q_idx = i * Q_BLOCK + jnp.arange(Q_BLOCK)
        causal = k_idx[None, :] <= q_idx[:, None]
        s = jnp.where(causal[None, None], s, -jnp.inf)
        p = jax.nn.softmax(s, axis=-1).astype(v.dtype)
        return jnp.einsum('bhqk,bkhd->bqhd', p, v)

    o = lax.map(attend_block, (qb, jnp.arange(nb)))
    return o.transpose(1, 0, 2, 3, 4).reshape(B, S, MLA_WIDTH)


def spatial_gating(u, v, v_norm_g, v_norm_b, w_s, b_s):
    u = jax.nn.gelu(u)
    v = layernorm(jax.nn.gelu(v), v_norm_g, v_norm_b)
    B, S, _ = v.shape
    nc = S // SGU_CHUNK
    vc = v.reshape(B, nc, SGU_CHUNK, SGU_GROUPS, SGU_GROUP_DIM)
    tril = jnp.tril(jnp.ones((SGU_CHUNK, SGU_CHUNK), dtype=bool))
    ws = jnp.where(tril[None], w_s, jnp.zeros_like(w_s))
    s = jnp.einsum('gts,bnsgc->bntgc', ws, vc) + b_s.T[None, None, :, :, None]
    return u * s.reshape(B, S, SGU_WIDTH)


def hierarchical_moe(h, w_rg, b_rg, w_re, b_re, w1, w3, w2):
    B, S, D = h.shape
    xf = h.reshape(-1, D)
    N = xf.shape[0]
    g_logits = (xf @ w_rg).astype(jnp.float32) + b_rg.astype(jnp.float32)
    g_prob = jax.nn.softmax(g_logits, axis=-1)
    grp = jnp.argmax(g_logits, axis=-1)
    p_grp = jnp.take_along_axis(g_prob, grp[:, None], axis=-1)
    e_logits = ((xf @ w_re).astype(jnp.float32) + b_re.astype(jnp.float32)).reshape(N, N_GROUPS, EXPERTS_PER_GROUP)
    e_in = jnp.take_along_axis(e_logits, grp[:, None, None], axis=1)[:, 0]
    e_prob = jax.nn.softmax(e_in, axis=-1)
    top_p, top_i = lax.top_k(e_prob, TOP_K)
    top_p = top_p / jnp.sum(top_p, axis=-1, keepdims=True)
    weights = p_grp * top_p
    experts = grp[:, None] * EXPERTS_PER_GROUP + top_i
    A = N * TOP_K
    flat_e = experts.reshape(-1)
    flat_tok = jnp.arange(A, dtype=jnp.int32) // TOP_K
    flat_w = weights.reshape(-1)
    order = jnp.argsort(flat_e)
    sorted_e = flat_e[order]
    counts = jnp.zeros((N_EXPERTS,), jnp.int32).at[flat_e].add(1)
    starts = jnp.cumsum(counts) - counts
    padded = ((counts + MOE_BLOCK - 1) // MOE_BLOCK) * MOE_BLOCK
    pad_ends = jnp.cumsum(padded)
    pad_starts = pad_ends - padded
    rank = jnp.arange(A, dtype=jnp.int32) - starts[sorted_e]
    dest = pad_starts[sorted_e] + rank
    P = ((A + MOE_BLOCK - 1) // MOE_BLOCK + N_EXPERTS) * MOE_BLOCK
    nblk = P // MOE_BLOCK
    slot_tok = jnp.zeros((P,), jnp.int32).at[dest].set(flat_tok[order])
    slot_w = jnp.zeros((P,), jnp.float32).at[dest].set(flat_w[order])
    blk_e = jnp.minimum(jnp.searchsorted(pad_ends, jnp.arange(nblk) * MOE_BLOCK, side='right'), N_EXPERTS - 1)
    x_blk = xf[slot_tok].reshape(nblk, MOE_BLOCK, D)

    def expert_block(args):
        xb, e = args
        return (jax.nn.silu(xb @ w1[e]) * (xb @ w3[e])) @ w2[e]

    y = lax.map(expert_block, (x_blk, blk_e)).reshape(P, D)
    out = jnp.zeros((N, D), jnp.float32).at[slot_tok].add(y.astype(jnp.float32) * slot_w[:, None])
    return out.astype(h.dtype).reshape(B, S, D)


def setup_inputs(seed: int = 0) -> dict:
    key = jax.random.key(seed)
    ks = jax.random.split(key, 32)
    f32 = jnp.float32

    def nrm(k, shape, fan_in, mult=1.0):
        return jax.random.normal(k, shape, f32) * (mult * fan_in ** -0.5)

    def gain(k, shape):
        return 1.0 + 0.02 * jax.random.normal(k, shape, f32)

    L = DEPTH
    x = jax.random.normal(ks[0], (BATCH, SEQ, D_MODEL), f32)
    c = jax.random.normal(ks[1], (BATCH, D_MODEL), f32)
    offs = jax.random.randint(ks[2], (BATCH, 1), 0, 4096, dtype=jnp.int32)
    positions = jnp.arange(SEQ, dtype=jnp.int32)[None, :] + offs
    return {
        "x": x,
        "c": c,
        "positions": positions,
        "w_ada": nrm(ks[3], (L, D_MODEL, N_MOD * D_MODEL), D_MODEL),
        "b_ada": 0.01 * jax.random.normal(ks[4], (L, N_MOD * D_MODEL), f32),
        "norm1_g": gain(ks[5], (L, D_MODEL)),
        "w_in": nrm(ks[6], (L, D_MODEL, IN_WIDTH), D_MODEL),
        "q_norm_g": gain(ks[7], (L, Q_LORA_RANK)),
        "w_uq": nrm(ks[8], (L, Q_LORA_RANK, MLA_HEADS * QK_DIM), Q_LORA_RANK),
        "kv_norm_g": gain(ks[9], (L, KV_LORA_RANK)),
        "w_ukv": nrm(ks[10], (L, KV_LORA_RANK, MLA_HEADS * (QK_NOPE_DIM + V_HEAD_DIM)), KV_LORA_RANK),
        "v_norm_g": gain(ks[11], (L, SGU_WIDTH)),
        "v_norm_b": 0.01 * jax.random.normal(ks[12], (L, SGU_WIDTH), f32),
        "w_s": nrm(ks[13], (L, SGU_GROUPS, SGU_CHUNK, SGU_CHUNK), SGU_CHUNK),
        "b_s": gain(ks[14], (L, SGU_GROUPS, SGU_CHUNK)),
        "w_br_mla": nrm(ks[15], (L, MLA_WIDTH, D_MODEL), MLA_WIDTH),
        "w_br_sgu": nrm(ks[16], (L, SGU_WIDTH, D_MODEL), SGU_WIDTH),
        "w_out": nrm(ks[17], (L, D_MODEL, D_MODEL), D_MODEL),
        "norm2_g": gain(ks[18], (L, D_MODEL)),
        "w_rg": nrm(ks[19], (L, D_MODEL, N_GROUPS), D_MODEL),
        "b_rg": 0.01 * jax.random.normal(ks[20], (L, N_GROUPS), f32),
        "w_re": nrm(ks[21], (L, D_MODEL, N_EXPERTS), D_MODEL),
        "b_re": 0.01 * jax.random.normal(ks[22], (L, N_EXPERTS), f32),
        "w1": nrm(ks[23], (L, N_EXPERTS, D_MODEL, EXPERT_FF), D_MODEL),
        "w3": nrm(ks[24], (L, N_EXPERTS, D_MODEL, EXPERT_FF), D_MODEL),
        "w2": nrm(ks[25], (L, N_EXPERTS, EXPERT_FF, D_MODEL), EXPERT_FF),
        "final_g": gain(ks[26], (D_MODEL,)),
    }


def reference(x, c, positions, w_ada, b_ada, norm1_g, w_in, q_norm_g, w_uq, kv_norm_g, w_ukv,
              v_norm_g, v_norm_b, w_s, b_s, w_br_mla, w_br_sgu, w_out, norm2_g,
              w_rg, b_rg, w_re, b_re, w1, w3, w2, final_g):
    split_idx = list(np.cumsum([Q_LORA_RANK, KV_LORA_RANK, QK_ROPE_DIM, SGU_WIDTH, SGU_WIDTH, D_MODEL])[:])
    for l in range(DEPTH):
        mod = jax.nn.silu(c) @ w_ada[l] + b_ada[l]
        shift1, scale1, gate1, shift2, scale2, gate2 = [m[:, None, :] for m in jnp.split(mod, N_MOD, axis=-1)]

        h1 = rmsnorm(x, norm1_g[l]) * (1.0 + scale1) + shift1
        proj = h1 @ w_in[l]
        c_q, c_kv, k_rope, sgu_u, sgu_v, gl_mla, gl_sgu = jnp.split(proj, split_idx, axis=-1)
        y_mla = mla(c_q, c_kv, k_rope, positions, q_norm_g[l], w_uq[l], kv_norm_g[l], w_ukv[l]) @ w_br_mla[l]
        y_sgu = spatial_gating(sgu_u, sgu_v, v_norm_g[l], v_norm_b[l], w_s[l], b_s[l]) @ w_br_sgu[l]
        merged = jax.nn.sigmoid(gl_mla) * y_mla + jax.nn.sigmoid(gl_sgu) * y_sgu
        x = x + gate1 * (merged @ w_out[l])

        h2 = rmsnorm(x, norm2_g[l]) * (1.0 + scale2) + shift2
        x = x + gate2 * hierarchical_moe(h2, w_rg[l], b_rg[l], w_re[l], b_re[l], w1[l], w3[l], w2[l])
    return rmsnorm(x, final_g)
```

```cpp
#include <hip/hip_runtime.h>
#include <hip/hip_bf16.h>
#include <cstdio>
#include <cstdint>
#include <cmath>

#ifndef MK_ONE_LAUNCH
#define MK_ONE_LAUNCH 0
#endif

#define LAS __attribute__((address_space(3)))
#define GAS __attribute__((address_space(1)))
typedef unsigned short bf16_t;
typedef short bf16x8 __attribute__((ext_vector_type(8)));
typedef short s16x4 __attribute__((ext_vector_type(4)));
typedef float f32x2 __attribute__((ext_vector_type(2)));
typedef float f32x4 __attribute__((ext_vector_type(4)));
typedef float f32x16 __attribute__((ext_vector_type(16)));
typedef unsigned u32x2 __attribute__((ext_vector_type(2)));
typedef unsigned u32x4 __attribute__((ext_vector_type(4)));
typedef __bf16 bf16x2_t __attribute__((ext_vector_type(2)));

__device__ __forceinline__ unsigned pk2(float lo, float hi) { f32x2 v = {lo, hi}; bf16x2_t b = __builtin_convertvector(v, bf16x2_t); return __builtin_bit_cast(unsigned, b); }
__device__ __forceinline__ float bflo(unsigned u) { return __uint_as_float(u << 16); }
__device__ __forceinline__ float bfhi(unsigned u) { return __uint_as_float(u & 0xffff0000u); }
__device__ __forceinline__ float bf2f(bf16_t h) { return __uint_as_float((unsigned)h << 16); }
__device__ __forceinline__ bf16_t f2bf(float f) { return (bf16_t)(pk2(f, 0.f) & 0xffffu); }
__device__ __forceinline__ float sigmoidf_(float x) { return __builtin_amdgcn_rcpf(1.0f + __builtin_amdgcn_exp2f(-1.4426950408889634f * x)); }
__device__ __forceinline__ float gelu_tanh(float x) { const float u = 0.7978845608028654f * (x + 0.044715f * x * x * x); return x * __builtin_amdgcn_rcpf(1.0f + __builtin_amdgcn_exp2f(-2.8853900817779268f * u)); }
__device__ __forceinline__ float wave_sum(float v) {
#pragma unroll
    for (int o = 1; o < 64; o <<= 1) v += __shfl_xor(v, o);
    return v;
}
__device__ __forceinline__ int opq(int x) { asm volatile("" : "+v"(x)); return x; }
#define LDS_WAIT() asm volatile("s_waitcnt lgkmcnt(0)" ::: "memory")
#define VM_WAIT() asm volatile("s_waitcnt vmcnt(0)" ::: "memory")

constexpr int NB = 2, SEQ = 16384, NTOK = NB * SEQ, DM = 1024;
constexpr int NH = 8, DQK = 96, QW = NH * DQK  ;
constexpr int INW = 3488, NPROJ = 3584;
constexpr int NEXP = 32, EFF = 512, ECAP = 32768;
constexpr float EPS = 1e-6f;
constexpr float C2 = 0.10206207261596577f * 1.4426950408889634f;
constexpr int NWAVES = 8;

constexpr size_t MiB = 1u << 20;
constexpr size_t WS_CTL = 0, CTL_ZERO_BYTES = 1 * MiB;
constexpr int CW_TMO = 0, CW_BAR = 4096, CW_CNT = 8192;
constexpr size_t WS_MOD = 65536;
constexpr size_t WS_SSQQ = 2 * MiB, WS_SSQKV = 3 * MiB;
constexpr size_t WS_WSTRIL = 1 * MiB;
constexpr size_t WS_CS = 4 * MiB;
constexpr size_t WS_LIST = 8 * MiB, WS_LW = 12 * MiB;
constexpr size_t WS_W13 = 16 * MiB, WS_W2 = 80 * MiB, WS_WIN = 112 * MiB, WS_WOUT = 119 * MiB, WS_WBR = 121 * MiB, WS_WUP = 123 * MiB;
constexpr size_t WS_GATES = 128 * MiB, WS_SGUU = 256 * MiB, WS_SGUV = 288 * MiB, WS_CQKV = 320 * MiB, WS_XN = 352 * MiB;
constexpr size_t WS_Q = 352 * MiB, WS_KN = 400 * MiB, WS_V = 432 * MiB, WS_KPE = 464 * MiB, WS_AO = 320 * MiB, WS_SO = 466 * MiB;
constexpr size_t WS_MERGED = 352 * MiB, WS_H2 = 128 * MiB, WS_HM = 192 * MiB, WS_Y = 264 * MiB, WS_END = 512 * MiB;

constexpr int RING_BYTES = 131072;
constexpr int MISC_OFF = RING_BYTES;
constexpr int TOKL_OFF = RING_BYTES + 1024;
constexpr int MAXU = 6;
constexpr int LDS_BYTES = 147456;
static_assert(TOKL_OFF + MAXU * 1024 <= LDS_BYTES, "LDS map");

namespace pg8 {
constexpr int BM = 256, BK = 64, HALF = 128, HTB = HALF * BK * 2, STAGE_BYTES = 8 * HTB, NXCD = 8, WGM = 8;
__host__ __device__ __forceinline__ int lds_byte(int r, int c) { const int st = (r >> 4) * 2 + (c >> 5), rr = r & 15, cc = c & 31, ob = rr * 64 + cc * 2; return st * 1024 + (ob ^ (((ob >> 9) & 1) << 5)); }
__host__ __device__ __forceinline__ void stage_rc(int b, int& R, int& C) { const int st = b / 1024, sb = b % 1024, swz = sb ^ (((sb >> 9) & 1) << 5); R = (st >> 1) * 16 + swz / 64; C = (st & 1) * 32 + (swz % 64) / 2; }
__host__ __device__ __forceinline__ int perm32(int rho) { const int n = rho >> 4, i = rho & 15; return 8 * (i >> 2) + 4 * n + (i & 3); }

struct Unit { int arow, acol, brow, pm, pn, e, cnt, aux; };
struct Gemm { const bf16_t* A; const bf16_t* Bt; int lda, K; };

struct GridMap {
    int nM, nN, nwg;
    __device__ __forceinline__ void init(int nM_, int nN_) { nM = nM_; nN = nN_; nwg = nM_ * nN_; }
    __device__ __forceinline__ bool map(long L, int& pm, int& pn) const {
        if (L >= nwg) return false;
        int wgid = (int)L; { const int q = nwg / NXCD, r = nwg % NXCD, xcd = wgid % NXCD, off = wgid / NXCD; wgid = (xcd < r ? xcd * (q + 1) : r * (q + 1) + (xcd - r) * q) + off; }
        const int nig = WGM * nN, gid = wgid / nig, fm = gid * WGM, gsz = (nM - fm) < WGM ? (nM - fm) : WGM;
        pm = fm + ((wgid % nig) % gsz); pn = (wgid % nig) / gsz; return true;
    }
};

template <class Epi, class Sched, bool GATHER>
__device__ __forceinline__ void gemm_phase(LAS unsigned char* lds, const Gemm g, const Sched& S, const Epi& E, const LAS unsigned* tokl) {
    const int tid = opq(threadIdx.x), wid = __builtin_amdgcn_readfirstlane(tid >> 6), lane = tid & 63, wr = wid >> 2, wc = wid & 3, fr = lane & 15, fq = lane >> 4;
    const int K = g.K, nt = K / BK, lda = g.lda;
    unsigned voffB[2], vA0c[2], vA1c[2], vA0n[2], vA1n[2]; int Rr[2]; unsigned Cb[2];
#pragma unroll
    for (int i = 0; i < 2; ++i) { int R, C; stage_rc(tid * 16 + i * 8192, R, C); const int Rb = Epi::PERM ? ((R & ~31) + perm32(R & 31)) : R;
        voffB[i] = (unsigned)(Rb * K + C) * 2u; Rr[i] = R; Cb[i] = (unsigned)C * 2u;
        vA0c[i] = (unsigned)(R * lda + C) * 2u; vA1c[i] = vA0c[i] + (unsigned)(HALF * lda) * 2u; vA0n[i] = vA0c[i]; vA1n[i] = vA1c[i]; }
    const size_t kstep = (size_t)(BK * 2);
    const size_t hstepB = (size_t)HALF * K * 2;
    const unsigned ldsw = (unsigned)wid * 1024u;
    const int aoff = lds_byte(wr * 64 + fr, fq * 8), boff = lds_byte(wc * 32 + fr, fq * 8);
#define PG8_SA(b, h) (((b) * 2 + (h)) * HTB)
#define PG8_SB(b, h) ((4 + (b) * 2 + (h)) * HTB)
#define PG8_STAGE(bufoff, gbase, voff) do { _Pragma("unroll") for (int _i = 0; _i < 2; ++_i) \
        __builtin_amdgcn_global_load_lds((const unsigned*)((const char*)(gbase) + (voff)[_i]), (LAS unsigned*)(lds + (bufoff) + ldsw + _i * 8192), 16, 0, 0); } while (0)
#define PG8_LDA(dst, b, h) do { _Pragma("unroll") for (int m = 0; m < 4; ++m) _Pragma("unroll") for (int k = 0; k < 2; ++k) dst[m][k] = *(const LAS bf16x8*)(lds + PG8_SA(b, h) + aoff + m * 2048 + k * 1024); } while (0)
#define PG8_LDB(dst, b, h) do { _Pragma("unroll") for (int n = 0; n < 2; ++n) _Pragma("unroll") for (int k = 0; k < 2; ++k) dst[n][k] = *(const LAS bf16x8*)(lds + PG8_SB(b, h) + boff + n * 2048 + k * 1024); } while (0)
#define PG8_MMA(ai, bj, At, Bt) do { __builtin_amdgcn_s_setprio(1); _Pragma("unroll") for (int m = 0; m < 4; ++m) _Pragma("unroll") for (int n = 0; n < 2; ++n) _Pragma("unroll") for (int k = 0; k < 2; ++k) \
        acc[ai][bj][m][n] = __builtin_amdgcn_mfma_f32_16x16x32_bf16(Bt[n][k], At[m][k], acc[ai][bj][m][n], 0, 0, 0); __builtin_amdgcn_s_setprio(0); } while (0)
#define PG8_WAIT_V(n) asm volatile("s_waitcnt vmcnt(" #n ")" ::: "memory")
#define PG8_WAIT_L(n) asm volatile("s_waitcnt lgkmcnt(" #n ")" ::: "memory")
#define PG8_BAR __builtin_amdgcn_s_barrier()
#define PG8_SCHED __builtin_amdgcn_sched_barrier(0)
    Unit cur, nxt; int ui = 0;
    if (!S.next(0, cur)) return;
    f32x4 acc[2][2][4][2];
#pragma unroll
    for (int a = 0; a < 2; ++a)
#pragma unroll
        for (int b = 0; b < 2; ++b)
#pragma unroll
            for (int m = 0; m < 4; ++m)
#pragma unroll
                for (int n = 0; n < 2; ++n) acc[a][b][m][n] = (f32x4){0.f, 0.f, 0.f, 0.f};
    bf16x8 At[4][2], B0[2][2], B1[2][2];
    if constexpr (GATHER) {
#pragma unroll
        for (int i = 0; i < 2; ++i) { vA0c[i] = tokl[Rr[i]] * (unsigned)(lda * 2) + Cb[i]; vA1c[i] = tokl[HALF + Rr[i]] * (unsigned)(lda * 2) + Cb[i]; }
    }
    const char* cA = GATHER ? (const char*)g.A : (const char*)g.A + ((size_t)cur.arow * lda + cur.acol) * 2;
    const char* cB = (const char*)g.Bt + (size_t)cur.brow * K * 2;
    PG8_STAGE(PG8_SB(0, 0), cB, voffB); PG8_STAGE(PG8_SB(0, 1), cB + hstepB, voffB); PG8_STAGE(PG8_SA(0, 0), cA, vA0c); PG8_STAGE(PG8_SA(0, 1), cA, vA1c);
    if (wr == 1) PG8_BAR;
    PG8_WAIT_V(2); PG8_BAR;
    PG8_STAGE(PG8_SB(1, 0), cB + kstep, voffB); PG8_STAGE(PG8_SA(1, 0), cA + kstep, vA0c); PG8_STAGE(PG8_SB(1, 1), cB + hstepB + kstep, voffB);
    PG8_WAIT_V(6); PG8_BAR;
    for (;;) {
        const bool has_next = S.next(ui + 1, nxt);
        const char* nA = cA; const char* nB = cB;
        if (has_next) { nA = GATHER ? (const char*)g.A : (const char*)g.A + ((size_t)nxt.arow * lda + nxt.acol) * 2; nB = (const char*)g.Bt + (size_t)nxt.brow * K * 2; }
        if constexpr (GATHER) {
            if (has_next) {
#pragma unroll
                for (int i = 0; i < 2; ++i) { vA0n[i] = tokl[(ui + 1) * 256 + Rr[i]] * (unsigned)(lda * 2) + Cb[i]; vA1n[i] = tokl[(ui + 1) * 256 + HALF + Rr[i]] * (unsigned)(lda * 2) + Cb[i]; }
            } else {
#pragma unroll
                for (int i = 0; i < 2; ++i) { vA0n[i] = vA0c[i]; vA1n[i] = vA1c[i]; }
            }
        }
#pragma unroll 1
        for (int t = 0; t < nt; t += 2) {
            const bool last = (t == nt - 2);
            const char* a1 = cA + (size_t)(t + 1) * kstep;
            const char* a2 = last ? nA : cA + (size_t)(t + 2) * kstep; const char* b2 = last ? nB : cB + (size_t)(t + 2) * kstep;
            const char* a3 = a2 + kstep; const char* b3 = b2 + kstep;
            unsigned s0[2], s1[2];
#pragma unroll
            for (int i = 0; i < 2; ++i) { s0[i] = (GATHER && last) ? vA0n[i] : vA0c[i]; s1[i] = (GATHER && last) ? vA1n[i] : vA1c[i]; }
            PG8_LDB(B0, 0, 0); PG8_LDB(B1, 0, 1); PG8_SCHED; PG8_LDA(At, 0, 0); PG8_STAGE(PG8_SA(1, 1), a1, vA1c);
            PG8_WAIT_V(8); PG8_WAIT_L(0); PG8_BAR; PG8_MMA(0, 0, At, B0); PG8_MMA(0, 1, At, B1); PG8_BAR; PG8_SCHED;
            PG8_LDA(At, 0, 1); PG8_STAGE(PG8_SB(0, 0), b2, voffB); PG8_STAGE(PG8_SB(0, 1), b2 + hstepB, voffB); PG8_STAGE(PG8_SA(0, 0), a2, s0);
            PG8_WAIT_V(8); PG8_WAIT_L(0); PG8_BAR; PG8_MMA(1, 0, At, B0); PG8_MMA(1, 1, At, B1); PG8_BAR; PG8_SCHED;
            PG8_LDB(B0, 1, 0); PG8_LDB(B1, 1, 1); PG8_SCHED; PG8_LDA(At, 1, 0); PG8_STAGE(PG8_SA(0, 1), a2, s1);
            PG8_WAIT_V(8); PG8_WAIT_L(0); PG8_BAR; PG8_MMA(0, 0, At, B0); PG8_MMA(0, 1, At, B1); PG8_BAR; PG8_SCHED;
            PG8_LDA(At, 1, 1); PG8_STAGE(PG8_SB(1, 0), b3, voffB); PG8_STAGE(PG8_SB(1, 1), b3 + hstepB, voffB); PG8_STAGE(PG8_SA(1, 0), a3, s0);
            PG8_WAIT_V(8); PG8_WAIT_L(0); PG8_BAR; PG8_MMA(1, 0, At, B0); PG8_MMA(1, 1, At, B1); PG8_BAR; PG8_SCHED;
        }
        if (wr == 0) PG8_BAR;
        E(acc, cur, wr, wc, fr, fq);
        if (!has_next) break;
#pragma unroll
        for (int a = 0; a < 2; ++a)
#pragma unroll
            for (int b = 0; b < 2; ++b)
#pragma unroll
                for (int m = 0; m < 4; ++m)
#pragma unroll
                    for (int n = 0; n < 2; ++n) acc[a][b][m][n] = (f32x4){0.f, 0.f, 0.f, 0.f};
        cur = nxt; cA = nA; cB = nB; ++ui;
        if constexpr (GATHER) {
#pragma unroll
            for (int i = 0; i < 2; ++i) { vA0c[i] = vA0n[i]; vA1c[i] = vA1n[i]; }
        }
        if (wr == 1) PG8_BAR;
    }
    PG8_WAIT_V(0);
    PG8_BAR;
#undef PG8_SA
#undef PG8_SB
#undef PG8_STAGE
#undef PG8_LDA
#undef PG8_LDB
#undef PG8_MMA
#undef PG8_WAIT_V
#undef PG8_WAIT_L
#undef PG8_BAR
#undef PG8_SCHED
}
}
using pg8::Unit;

__device__ __forceinline__ u32x4 pack8(const f32x4& a, const f32x4& b) { u32x4 w; w.x = pk2(a[0], a[1]); w.y = pk2(a[2], a[3]); w.z = pk2(b[0], b[1]); w.w = pk2(b[2], b[3]); return w; }

struct EpiProj {
    static constexpr bool PERM = true;
    bf16_t *cqkv, *sguu, *sguv, *gates; float *ssqq, *ssqkv;
    __device__ __forceinline__ void operator()(const f32x4 (&acc)[2][2][4][2], const Unit& u, int wr, int wc, int fr, int fq) const {
        fr = opq(fr); fq = opq(fq);
        const int pn = u.pn, row0 = u.pm * 256 + wr * 64 + fr;
        bf16_t* base; int ld, act, colt;
        if (pn < 2) { base = cqkv; ld = 512; act = 0; colt = pn * 256; }
        else if (pn < 4) { base = sguu; ld = 512; act = 1; colt = (pn - 2) * 256; }
        else if (pn < 6) { base = sguv; ld = 512; act = 1; colt = (pn - 4) * 256; }
        else { base = gates; ld = 2048; act = 2; colt = (pn - 6) * 256; }
        const int col0 = colt + wc * 32 + 8 * fq;
#pragma unroll
        for (int ai = 0; ai < 2; ++ai)
#pragma unroll
            for (int m = 0; m < 4; ++m) {
                const int row = row0 + ai * 128 + m * 16; bf16_t* rowp = base + (size_t)row * ld + col0; float ss = 0.f;
#pragma unroll
                for (int bj = 0; bj < 2; ++bj) { f32x4 v0 = acc[ai][bj][m][0], v1 = acc[ai][bj][m][1];
                    if (act == 0) { if (pn == 0 || bj == 0) ss += (v0[0] * v0[0] + v0[1] * v0[1]) + (v0[2] * v0[2] + v0[3] * v0[3]) + (v1[0] * v1[0] + v1[1] * v1[1]) + (v1[2] * v1[2] + v1[3] * v1[3]); }
                    else if (act == 1) {
#pragma unroll
                        for (int j = 0; j < 4; ++j) { v0[j] = gelu_tanh(v0[j]); v1[j] = gelu_tanh(v1[j]); } }
                    else {
#pragma unroll
                        for (int j = 0; j < 4; ++j) { v0[j] = sigmoidf_(v0[j]); v1[j] = sigmoidf_(v1[j]); } }
                    *(u32x4*)(rowp + bj * 128) = pack8(v0, v1); }
                if (pn < 2) { ss += __shfl_xor(ss, 16); ss += __shfl_xor(ss, 32);
                    if (fq == 0) (pn == 0 ? ssqq : ssqkv)[(size_t)row * 4 + wc] = ss; }
                asm volatile("" ::: "memory");
            }
    }
};

struct EpiUp {
    static constexpr bool PERM = true;
    bf16_t *q, *kn, *v; const float *ssqq, *ssqkv; const f32x4* cs;
    __device__ __forceinline__ void operator()(const f32x4 (&acc)[2][2][4][2], const Unit& u, int wr, int wc, int fr, int fq) const {
        fr = opq(fr); fq = opq(fq);
        const int pn = u.pn, row0 = u.pm * 256 + wr * 64 + fr;
#pragma unroll
        for (int ai = 0; ai < 2; ++ai)
#pragma unroll
            for (int m = 0; m < 4; ++m) {
                const int row = row0 + ai * 128 + m * 16;
                if (pn < 3) {
                    const f32x4 sp = *(const f32x4*)(ssqq + (size_t)row * 4); const float rs = 1.0f / sqrtf(((sp[0] + sp[1]) + (sp[2] + sp[3])) * (1.0f / 256.0f) + EPS);
#pragma unroll
                    for (int bj = 0; bj < 2; ++bj) { const int gg = 8 * pn + 4 * bj + wc, col = 256 * pn + 128 * bj + 32 * wc + 8 * fq;
                        f32x4 v0 = acc[ai][bj][m][0] * rs, v1 = acc[ai][bj][m][1] * rs;
                        if (gg % 3 == 2) { const f32x4 c01 = cs[(size_t)row * 8 + 2 * fq], c23 = cs[(size_t)row * 8 + 2 * fq + 1];
                            const float cc[4] = {c01[0], c01[2], c23[0], c23[2]}, sn[4] = {c01[1], c01[3], c23[1], c23[3]};
#pragma unroll
                            for (int j = 0; j < 4; ++j) { const float x1 = v0[j], x2 = v1[j]; v0[j] = x1 * cc[j] - x2 * sn[j]; v1[j] = x1 * sn[j] + x2 * cc[j]; } }
                        *(u32x4*)(q + (size_t)row * QW + col) = pack8(v0, v1); }
                } else {
                    const f32x4 sp = *(const f32x4*)(ssqkv + (size_t)row * 4); const float rs = 1.0f / sqrtf(((sp[0] + sp[1]) + (sp[2] + sp[3])) * (1.0f / 128.0f) + EPS);
#pragma unroll
                    for (int bj = 0; bj < 2; ++bj) { const int h = 2 * (pn - 3) + bj, cc = 32 * wc + 8 * fq;
                        bf16_t* dst = (wc < 2) ? kn + (size_t)row * 512 + h * 64 + cc : v + (size_t)row * 512 + h * 64 + cc - 64;
                        *(u32x4*)dst = pack8(acc[ai][bj][m][0] * rs, acc[ai][bj][m][1] * rs); }
                }
                asm volatile("" ::: "memory");
            }
    }
};

struct EpiBranch {
    static constexpr bool PERM = true;
    const bf16_t* gates; bf16_t* merged;
    __device__ __forceinline__ void operator()(const f32x4 (&acc)[2][2][4][2], const Unit& u, int wr, int wc, int fr, int fq) const {
        fr = opq(fr); fq = opq(fq);
        const int row0 = u.pm * 256 + wr * 64 + fr, br = u.e;
#pragma unroll
        for (int ai = 0; ai < 2; ++ai)
#pragma unroll
            for (int m = 0; m < 4; ++m) { const int row = row0 + ai * 128 + m * 16;
#pragma unroll
                for (int bj = 0; bj < 2; ++bj) { const int col = 256 * u.pn + 128 * bj + 32 * wc + 8 * fq;
                    const u32x4 gw = *(const u32x4*)(gates + (size_t)row * 2048 + br * 1024 + col);
                    f32x4 v0 = acc[ai][bj][m][0], v1 = acc[ai][bj][m][1];
                    v0[0] *= bflo(gw.x); v0[1] *= bfhi(gw.x); v0[2] *= bflo(gw.y); v0[3] *= bfhi(gw.y); v1[0] *= bflo(gw.z); v1[1] *= bfhi(gw.z); v1[2] *= bflo(gw.w); v1[3] *= bfhi(gw.w);
                    bf16_t* dst = merged + (size_t)row * 1024 + col;
                    if (br) { const u32x4 pw = *(const u32x4*)dst;
                        v0[0] += bflo(pw.x); v0[1] += bfhi(pw.x); v0[2] += bflo(pw.y); v0[3] += bfhi(pw.y); v1[0] += bflo(pw.z); v1[1] += bfhi(pw.z); v1[2] += bflo(pw.w); v1[3] += bfhi(pw.w); }
                    *(u32x4*)dst = pack8(v0, v1); }
                asm volatile("" ::: "memory"); }
    }
};

struct EpiOut {
    static constexpr bool PERM = false;
    const float* x; const float* mod; float* out;
    __device__ __forceinline__ void operator()(const f32x4 (&acc)[2][2][4][2], const Unit& u, int wr, int wc, int fr, int fq) const {
        fr = opq(fr); fq = opq(fq);
        const int row0 = u.pm * 256 + wr * 64 + fr, col0 = u.pn * 256 + wc * 32 + 4 * fq; const float* g1 = mod + (u.pm >> 6) * 6144 + 2048;
        f32x4 gv[2][2];
#pragma unroll
        for (int bj = 0; bj < 2; ++bj)
#pragma unroll
            for (int n = 0; n < 2; ++n) gv[bj][n] = *(const f32x4*)(g1 + col0 + bj * 128 + n * 16);
#pragma unroll
        for (int ai = 0; ai < 2; ++ai)
#pragma unroll
            for (int m = 0; m < 4; ++m) { const size_t off = (size_t)(row0 + ai * 128 + m * 16) * DM + col0;
#pragma unroll
                for (int bj = 0; bj < 2; ++bj)
#pragma unroll
                    for (int n = 0; n < 2; ++n) { const f32x4 xv = *(const f32x4*)(x + off + bj * 128 + n * 16); *(f32x4*)(out + off + bj * 128 + n * 16) = xv + gv[bj][n] * acc[ai][bj][m][n]; } }
    }
};

struct EpiMoe1 {
    static constexpr bool PERM = true;
    bf16_t* hm;
    __device__ __forceinline__ void operator()(const f32x4 (&acc)[2][2][4][2], const Unit& u, int wr, int wc, int fr, int fq) const {
        fr = opq(fr); fq = opq(fq);
        const int row0 = u.pm * 256 + wr * 64 + fr, col = 128 * u.pn + 32 * wc + 8 * fq;
#pragma unroll
        for (int ai = 0; ai < 2; ++ai)
#pragma unroll
            for (int m = 0; m < 4; ++m) { f32x4 h0, h1;
#pragma unroll
                for (int j = 0; j < 4; ++j) { const float a0 = acc[ai][0][m][0][j], a1 = acc[ai][0][m][1][j]; h0[j] = a0 * sigmoidf_(a0) * acc[ai][1][m][0][j]; h1[j] = a1 * sigmoidf_(a1) * acc[ai][1][m][1][j]; }
                *(u32x4*)(hm + (size_t)(row0 + ai * 128 + m * 16) * EFF + col) = pack8(h0, h1); }
    }
};

struct EpiMoe2 {
    static constexpr bool PERM = true;
    const unsigned* list; const float* lw; bf16_t* y;
    __device__ __forceinline__ void operator()(const f32x4 (&acc)[2][2][4][2], const Unit& u, int wr, int wc, int fr, int fq) const {
        fr = opq(fr); fq = opq(fq);
#pragma unroll
        for (int ai = 0; ai < 2; ++ai)
#pragma unroll
            for (int m = 0; m < 4; ++m) { const int r = ai * 128 + wr * 64 + m * 16 + fr;
                if (r < u.cnt) { const size_t idx = (size_t)u.e * ECAP + u.aux * 256 + r; const unsigned tk = list[idx]; const float w = lw[idx];
#pragma unroll
                    for (int bj = 0; bj < 2; ++bj) *(u32x4*)(y + (size_t)tk * DM + 256 * u.pn + 128 * bj + 32 * wc + 8 * fq) = pack8(acc[ai][bj][m][0] * w, acc[ai][bj][m][1] * w); }
                asm volatile("" ::: "memory"); }
    }
};

struct OrderGrid {
    pg8::GridMap gm; int G, c, split_pn, acol_hi;
    __device__ __forceinline__ bool next(int i, Unit& u) const { int pm, pn; if (!gm.map((long)i * G + c, pm, pn)) return false;
        u.pm = pm; u.pn = pn; u.arow = pm * 256; u.acol = (pn >= split_pn) ? acol_hi : 0; u.brow = pn * 256; u.e = 0; u.cnt = 256; u.aux = 0; return true; }
};
struct OrderBranch {
    pg8::GridMap gm; int G, c;
    __device__ __forceinline__ bool next(int i, Unit& u) const { int pm, pn; if (!gm.map((long)(i >> 1) * G + c, pm, pn)) return false; const int br = i & 1;
        u.pm = pm; u.pn = pn; u.arow = pm * 256; u.acol = br * 512; u.brow = br * 1024 + pn * 256; u.e = br; u.cnt = 256; u.aux = 0; return true; }
};
struct OrderMoe {
    const volatile LAS unsigned* tp; const unsigned* cnt; int G, c;
    __device__ __forceinline__ bool next(int i, Unit& u) const {
        const int T = (int)tp[33], nwg = 4 * T; const long L = (long)i * G + c; if (L >= nwg) return false;
        int wgid = (int)L; { const int q = nwg / 8, r = nwg % 8, xcd = wgid % 8, off = wgid / 8; wgid = (xcd < r ? xcd * (q + 1) : r * (q + 1) + (xcd - r) * q) + off; }
        const int ti = wgid >> 2, pn = wgid & 3; int e = 0;
        for (int j = 1; j < NEXP; ++j) if ((int)tp[j] <= ti) e = j;
        const int tile = ti - (int)tp[e]; int rem = (int)cnt[e] - tile * 256; rem = rem > 256 ? 256 : rem;
        u.pm = ti; u.pn = pn; u.arow = ti * 256; u.acol = 0; u.brow = e * 1024 + pn * 256; u.e = e; u.cnt = rem; u.aux = tile; return true; }
};

namespace attn {
#define SBAR() __builtin_amdgcn_sched_barrier(0)
__device__ __forceinline__ int crow(int r, int hi) { return (r & 3) + 8 * (r >> 2) + 4 * hi; }
constexpr int KSLOT = 12288, VSLOT = 8192;
constexpr int LDS_K = 0, LDS_V = 2 * KSLOT, LDS_WS = LDS_V + 2 * VSLOT, LDS_OST = LDS_WS + NWAVES * 64 * 4, LDS_END = LDS_OST + NWAVES * 4096;
static_assert(LDS_END <= RING_BYTES, "attention LDS");
__device__ __forceinline__ void glds16(const void* gsrc, unsigned lds_dst) { unsigned keep;
    asm volatile("s_mov_b32 %0, m0\n\ts_mov_b32 m0, %2\n\ts_nop 0\n\tglobal_load_lds_dwordx4 %1, off\n\ts_mov_b32 m0, %0" : "=&s"(keep) : "v"(gsrc), "s"(lds_dst) : "memory"); }
__device__ __forceinline__ void cmask(f32x16& p0, f32x16& p1, int jb, int qrel, int hi) {
    const float NEG = -INFINITY; const int kb = 64 * jb + 4 * hi;
#pragma unroll
    for (int r = 0; r < 16; ++r) { const int kv = kb + (r & 3) + 8 * (r >> 2); if (kv > qrel) p0[r] = NEG; if (kv + 32 > qrel) p1[r] = NEG; }
}
__device__ __forceinline__ void qkt(f32x16& p0, f32x16& p1, const char* Kslot, const bf16x8* qr, int r32, int hi) {
    const char* kb = Kslot + hi * 1024 + r32 * 16;
    p0 = f32x16{}; p1 = f32x16{};
#pragma unroll
    for (int d0 = 0; d0 < 6; ++d0) {
        const bf16x8 b0 = *reinterpret_cast<const bf16x8*>(kb + d0 * 2048);
        const bf16x8 b1 = *reinterpret_cast<const bf16x8*>(kb + d0 * 2048 + 512);
        p0 = __builtin_amdgcn_mfma_f32_32x32x16_bf16(b0, qr[d0], p0, 0, 0, 0); p1 = __builtin_amdgcn_mfma_f32_32x32x16_bf16(b1, qr[d0], p1, 0, 0, 0); }
}
__device__ __forceinline__ void pv(f32x16* o, int vb, bf16x8 pa0, bf16x8 pa1, bf16x8 pa2, bf16x8 pa3) {
#pragma unroll
    for (int d0 = 0; d0 < 2; ++d0) { s16x4 lo[4], hi[4];
#pragma unroll
        for (int ks = 0; ks < 4; ++ks) {
            asm volatile("ds_read_b64_tr_b16 %0,%1 offset:%c2" : "=&v"(lo[ks]) : "v"(vb), "i"(d0 * 4096 + ks * 1024) : "memory");
            asm volatile("ds_read_b64_tr_b16 %0,%1 offset:%c2" : "=&v"(hi[ks]) : "v"(vb), "i"(d0 * 4096 + ks * 1024 + 512) : "memory"); }
        asm volatile("s_waitcnt lgkmcnt(0)" ::: "memory"); SBAR();
#define PK(k) (bf16x8){lo[k][0], lo[k][1], lo[k][2], lo[k][3], hi[k][0], hi[k][1], hi[k][2], hi[k][3]}
        o[d0] = __builtin_amdgcn_mfma_f32_32x32x16_bf16(pa0, PK(0), o[d0], 0, 0, 0);
        o[d0] = __builtin_amdgcn_mfma_f32_32x32x16_bf16(pa1, PK(1), o[d0], 0, 0, 0);
        o[d0] = __builtin_amdgcn_mfma_f32_32x32x16_bf16(pa2, PK(2), o[d0], 0, 0, 0);
        o[d0] = __builtin_amdgcn_mfma_f32_32x32x16_bf16(pa3, PK(3), o[d0], 0, 0, 0);
#undef PK
    }
}
__device__ __forceinline__ void attn_unit(int b, int h, int qb, const bf16_t* Q, const bf16_t* KN, const bf16_t* KPE, const bf16_t* V, bf16_t* O, char* shm) {
    const int tid = opq(threadIdx.x), lane = tid & 63, r32 = lane & 31, hi = lane >> 5; const int wid = __builtin_amdgcn_readfirstlane(tid >> 6);
    const long rowbase = (long)b * SEQ; const int q0 = qb * 256;
    const bf16_t* Qw = Q + (rowbase + q0 + wid * 32) * QW + h * DQK;
    const unsigned lds0 = (unsigned)(uintptr_t)shm;
    float* wsf = (float*)(shm + LDS_WS) + wid * 64;
    const bf16_t* ksrc = KN + (rowbase + lane) * 512 + h * 64 + wid * 8;
    const bf16_t* psrc = KPE + (rowbase + lane) * 32 + (wid & 3) * 8;
    const bf16_t* vsrc = V + (rowbase + 16 * (wid & 3) + (lane >> 2)) * 512 + h * 64 + (wid >> 2) * 32 + (lane & 3) * 8;
    const unsigned kdst = lds0 + LDS_K + wid * 1024, pdst = lds0 + LDS_K + (8 + (wid & 3)) * 1024, vdst = lds0 + LDS_V + wid * 1024;
    const int vb0 = (int)(lds0 + LDS_V) + ((lane >> 4) & 1) * 32 + (lane & 3) * 8 + (4 * hi + ((lane & 15) >> 2)) * 64;
    bf16x8 qr[6];
#pragma unroll
    for (int d0 = 0; d0 < 6; ++d0) qr[d0] = *reinterpret_cast<const bf16x8*>(&Qw[(long)r32 * QW + d0 * 16 + hi * 8]);
    float mrun = -INFINITY, l_reg = 0.f; f32x16 o[2]; o[0] = f32x16{}; o[1] = f32x16{};
    const int qrel = wid * 32 + r32; const int NT = (q0 + 256) / 64;
#define DMA_TILE(t, s) do { glds16(ksrc + (long)(t) * 64 * 512, (unsigned)__builtin_amdgcn_readfirstlane(kdst + (s) * KSLOT)); \
        glds16(psrc + (long)(t) * 64 * 32, (unsigned)__builtin_amdgcn_readfirstlane(pdst + (s) * KSLOT)); \
        glds16(vsrc + (long)(t) * 64 * 512, (unsigned)__builtin_amdgcn_readfirstlane(vdst + (s) * VSLOT)); } while (0)
    DMA_TILE(0, 0);
    for (int t = 0; t < NT; ++t) {
        const int s = t & 1;
        asm volatile("s_waitcnt vmcnt(0) lgkmcnt(0)\n\ts_barrier" ::: "memory");
        if (t + 1 < NT) DMA_TILE(t + 1, s ^ 1);
        f32x16 p0, p1;
        qkt(p0, p1, shm + LDS_K + s * KSLOT, qr, r32, hi);
        { const int jb = t - (NT - 4); if (jb >= 0) cmask(p0, p1, jb, qrel, hi); }
        float rm = p0[0];
#pragma unroll
        for (int r = 0; r < 16; ++r) { rm = fmaxf(rm, p0[r]); rm = fmaxf(rm, p1[r]); }
        { auto rr = __builtin_amdgcn_permlane32_swap(__float_as_uint(rm), __float_as_uint(rm), false, false); rm = fmaxf(__uint_as_float(rr[0]), __uint_as_float(rr[1])); }
        const float mnew = fmaxf(mrun, rm);
        const float f = __builtin_amdgcn_exp2f(mrun - mnew); mrun = mnew;
        float sacc = 0.f;
#pragma unroll
        for (int r = 0; r < 16; ++r) { p0[r] = __builtin_amdgcn_exp2f(p0[r] - mnew); p1[r] = __builtin_amdgcn_exp2f(p1[r] - mnew); sacc += p0[r] + p1[r]; }
        l_reg = l_reg * f + sacc;
        if (hi == 0) wsf[r32] = f;
        asm volatile("s_waitcnt lgkmcnt(0)" ::: "memory");
#pragma unroll
        for (int r = 0; r < 16; ++r) { const float fr_ = wsf[crow(r, hi)]; o[0][r] *= fr_; o[1][r] *= fr_; }
        u32x4 pw0, pw1, pw2, pw3;
        pw0 = (u32x4){pk2(p0[0], p0[1]), pk2(p0[2], p0[3]), pk2(p0[4], p0[5]), pk2(p0[6], p0[7])};
        pw1 = (u32x4){pk2(p0[8], p0[9]), pk2(p0[10], p0[11]), pk2(p0[12], p0[13]), pk2(p0[14], p0[15])};
        pw2 = (u32x4){pk2(p1[0], p1[1]), pk2(p1[2], p1[3]), pk2(p1[4], p1[5]), pk2(p1[6], p1[7])};
        pw3 = (u32x4){pk2(p1[8], p1[9]), pk2(p1[10], p1[11]), pk2(p1[12], p1[13]), pk2(p1[14], p1[15])};
        SBAR();
        pv(o, vb0 + s * VSLOT, __builtin_bit_cast(bf16x8, pw0), __builtin_bit_cast(bf16x8, pw1), __builtin_bit_cast(bf16x8, pw2), __builtin_bit_cast(bf16x8, pw3));
    }
#undef DMA_TILE
    { auto rr = __builtin_amdgcn_permlane32_swap(__float_as_uint(l_reg), __float_as_uint(l_reg), false, false); l_reg = __uint_as_float(rr[0]) + __uint_as_float(rr[1]); }
    if (hi == 0) wsf[32 + r32] = l_reg; asm volatile("s_waitcnt lgkmcnt(0)" ::: "memory");
    float rli[16];
#pragma unroll
    for (int r = 0; r < 16; ++r) rli[r] = __builtin_amdgcn_rcpf(wsf[32 + crow(r, hi)]);
    bf16_t* Ow = O + (rowbase + q0 + wid * 32) * 512 + h * 64;
    { bf16_t* stg = (bf16_t*)(shm + LDS_OST) + wid * 2048;
#pragma unroll
        for (int r = 0; r < 16; ++r) { const int orow = crow(r, hi);
#pragma unroll
            for (int d0 = 0; d0 < 2; ++d0) stg[orow * 64 + d0 * 32 + r32] = f2bf(o[d0][r] * rli[r]); }
        asm volatile("s_waitcnt lgkmcnt(0)" ::: "memory");
#pragma unroll
        for (int i = 0; i < 4; ++i) { const int row = i * 8 + (lane >> 3), ch = lane & 7; const u32x4 v = *(const u32x4*)(stg + row * 64 + ch * 8); *(u32x4*)(Ow + (long)row * 512 + ch * 8) = v; } }
    asm volatile("s_waitcnt vmcnt(0) lgkmcnt(0)\n\ts_barrier" ::: "memory");
}
#undef SBAR
}

typedef GAS unsigned gu32;
#define RLX_AGENT __ATOMIC_RELAXED, __HIP_MEMORY_SCOPE_AGENT
#define XB_TMO      128
#define XB_XCNT(j)  (256  + 64 * (j))
#define XB_XSUB(j)  (1280 + 64 * (j))
#define XB_XGEN(j)  (2304 + 64 * (j))
#define XB_TOP      3328
#define XB_TOPGEN   3392
#define XCD_BAR_WORDS 3456
#define XB_SPIN_CAP (1u << 22)
__device__ __forceinline__ unsigned xb_ld(unsigned* p)              { return __hip_atomic_load(p, __ATOMIC_RELAXED, __HIP_MEMORY_SCOPE_AGENT); }
__device__ __forceinline__ unsigned xb_add(unsigned* p, unsigned v) { return __hip_atomic_fetch_add(p, v, __ATOMIC_RELAXED, __HIP_MEMORY_SCOPE_AGENT); }
__device__ __forceinline__ unsigned xb_xcc_id() { return (unsigned)__builtin_amdgcn_s_getreg((3 << 11) | 20) & 0xFu; }
#define XB_SPIN(cond, bar) do { unsigned _sp = 0; while (cond) { __builtin_amdgcn_s_sleep(1); \
    if ((++_sp & 255u) == 0u) { if (xb_ld(&(bar)[XB_TMO])) break; if (_sp > XB_SPIN_CAP) { atomicAdd(&(bar)[XB_TMO], 1u); break; } } } } while (0)
struct XcdBarrier { unsigned* bar; unsigned x; volatile LAS unsigned* st; };
__device__ __forceinline__ XcdBarrier xcd_barrier_post(unsigned* bar, volatile LAS unsigned* st) {
    XcdBarrier b; b.bar = bar; b.x = xb_xcc_id(); b.st = st;
    if (threadIdx.x == 0) (void)xb_add(&bar[XB_XCNT(b.x)], 1u);
    return b;
}
__device__ __forceinline__ void xcd_barrier_complete(unsigned* bar, unsigned x, unsigned& nloc, unsigned& nx) {
    const unsigned G = gridDim.x * gridDim.y * gridDim.z;
    unsigned sum, cnt, mine, sp = 0u;
    for (;;) {
        sum = 0u; cnt = 0u; mine = 0u;
#pragma unroll
        for (unsigned j = 0; j < 16; ++j) { const unsigned c = xb_ld(&bar[XB_XCNT(j)]); sum += c; cnt += (c > 0u) ? 1u : 0u; mine = (j == x) ? c : mine; }
        if (sum == G) break;
        __builtin_amdgcn_s_sleep(1);
        if ((++sp & 255u) == 0u) { if (xb_ld(&bar[XB_TMO])) break; if (sp > XB_SPIN_CAP) { atomicAdd(&bar[XB_TMO], 1u); break; } }
    }
    nloc = mine > 0u ? mine : 1u; nx = cnt > 0u ? cnt : 1u;
}
__device__ __forceinline__ void xcd_barrier(const XcdBarrier& b) {
    asm volatile("s_waitcnt vmcnt(0)" ::: "memory");
    __syncthreads();
    if (threadIdx.x == 0) {
        unsigned* bar = b.bar;
        __builtin_amdgcn_s_waitcnt(0);
        unsigned nloc = b.st[0], nx = b.st[1];
        if (nloc == 0u) { xcd_barrier_complete(bar, b.x, nloc, nx); b.st[0] = nloc; b.st[1] = nx; }
        const unsigned old = xb_add(&bar[XB_XSUB(b.x)], 1u);
        const unsigned gen = old / nloc;
        if (old + 1u == (gen + 1u) * nloc) {
            __builtin_amdgcn_fence(__ATOMIC_RELEASE, "agent");
            asm volatile("s_waitcnt vmcnt(0)" ::: "memory");
            const unsigned og = xb_add(&bar[XB_TOP], 1u);
            const unsigned tg = og / nx;
            if (og + 1u == (tg + 1u) * nx) xb_add(&bar[XB_TOPGEN], 1u);
            else XB_SPIN(xb_ld(&bar[XB_TOPGEN]) == tg, bar);
            __builtin_amdgcn_fence(__ATOMIC_ACQUIRE, "agent");
            xb_add(&bar[XB_XGEN(b.x)], 1u);
            asm volatile("s_waitcnt vmcnt(0)" ::: "memory");
        } else {
            XB_SPIN(xb_ld(&bar[XB_XGEN(b.x)]) == gen, bar);
            __builtin_amdgcn_fence(__ATOMIC_ACQUIRE, "agent");
            asm volatile("s_waitcnt vmcnt(0)" ::: "memory");
        }
    }
    __syncthreads();
}

struct Args { const void* in[27]; float* out; unsigned char* ws; int ph_lo, ph_hi; };
enum { I_X = 0, I_C, I_POS, I_WADA, I_BADA, I_N1G, I_WIN, I_QNG, I_WUQ, I_KVNG, I_WUKV, I_VNG, I_VNB, I_WS, I_BS, I_WBRM, I_WBRS, I_WOUT, I_N2G, I_WRG, I_BRG, I_WRE, I_BRE, I_W1, I_W3, I_W2, I_FG };
constexpr int NPHASE = 12;

__device__ __forceinline__ int ropeidx(int p) { return 4 * (p >> 3) + (p & 3) + 16 * ((p >> 2) & 1); }

__device__ __forceinline__ void tr_item(const float* W, int N, int k0, int n0, bf16_t* WT, int ldk, int drow0, const float* gk, float mul, bool rp, LAS float* scr, int lane) {
#pragma unroll 8
    for (int i = 0; i < 32; ++i) { const int kk = 2 * i + (lane >> 5); float v = W[(size_t)(k0 + kk) * N + n0 + (lane & 31)]; if (gk) v *= gk[k0 + kk]; scr[kk * 33 + (lane & 31)] = v * mul; }
    LDS_WAIT(); asm volatile("" ::: "memory");
    const int c = lane & 7;
#pragma unroll
    for (int j = 0; j < 4; ++j) { const int p = (lane >> 3) + 8 * j; const int n = rp ? ropeidx(p) : p; const LAS float* s = scr + (8 * c) * 33 + n;
        u32x4 o; o.x = pk2(s[0 * 33], s[1 * 33]); o.y = pk2(s[2 * 33], s[3 * 33]); o.z = pk2(s[4 * 33], s[5 * 33]); o.w = pk2(s[6 * 33], s[7 * 33]);
        *(u32x4*)(WT + (size_t)(drow0 + p) * ldk + k0 + 8 * c) = o; }
    LDS_WAIT(); asm volatile("" ::: "memory");
}
__device__ __forceinline__ int win_drow(int n) {
    if (n < 416) return n; if (n < 928) return n + 96; if (n < 1440) return n + 96; if (n < 2464) return n + 96; return n + 96;
}

__global__ void __launch_bounds__(NWAVES * 64, 2) fwd_kernel(Args args) {
    extern __shared__ __attribute__((aligned(16))) unsigned char lds[];
    LAS unsigned char* const L = (LAS unsigned char*)lds;
    volatile LAS unsigned* const MISC = (volatile LAS unsigned*)(L + MISC_OFF);
    const int tid0 = threadIdx.x, wave = __builtin_amdgcn_readfirstlane(tid0 >> 6);
    const int G = gridDim.x; const int bx = blockIdx.x; const int vcu = (G % 8 == 0) ? (bx % 8) * (G / 8) + bx / 8 : bx;
    const int gw = vcu * NWAVES + wave, NGW = G * NWAVES;
    unsigned char* const ws = args.ws;
    unsigned* const ctl = (unsigned*)(ws + WS_CTL);
    float* const mod = (float*)(ws + WS_MOD);
    float* const ssqq = (float*)(ws + WS_SSQQ); float* const ssqkv = (float*)(ws + WS_SSQKV);
    unsigned* const ecnt = ctl + CW_CNT;
    const float* const x = (const float*)args.in[I_X];
    float* const out = args.out;
    for (int u = tid0; u < 64; u += NWAVES * 64) MISC[u] = 0u;
    __syncthreads();
    const int lo = args.ph_lo, hi = args.ph_hi;
    XcdBarrier bar; bar.bar = ctl + CW_BAR; bar.x = 0; bar.st = nullptr;
    if (hi - lo > 1) bar = xcd_barrier_post(ctl + CW_BAR, MISC + 8);
#ifndef PH_MASK
#define PH_MASK 0xFFF
#endif
#define IN(k) (((PH_MASK >> (k)) & 1) && lo <= (k) && (k) < hi)
#define SEAM(k) do { if (IN(k) && IN((k) + 1)) xcd_barrier(bar); } while (0)

    if (IN(0)) {
        const int tid = opq(tid0), lane = tid & 63; (void)tid;
        LAS float* scr = (LAS float*)(L + wave * 16384);
        bf16_t* const WIN = (bf16_t*)(ws + WS_WIN); bf16_t* const WUP = (bf16_t*)(ws + WS_WUP); bf16_t* const WBR = (bf16_t*)(ws + WS_WBR);
        bf16_t* const WOUT = (bf16_t*)(ws + WS_WOUT); bf16_t* const W13 = (bf16_t*)(ws + WS_W13); bf16_t* const W2 = (bf16_t*)(ws + WS_W2);
        constexpr int I_IN = 16 * 109, I_UQ = 4 * 24, I_UKV = 2 * 32, I_BR = 8 * 32, I_OUT = 16 * 32, I_E13 = 16 * 16, I_E2 = 8 * 32;
        constexpr int NIT = I_IN + I_UQ + I_UKV + 2 * I_BR + I_OUT + NEXP * (2 * I_E13 + I_E2);
        for (int it = gw; it < NIT; it += NGW) {
            int r = it;
            if (r < I_IN) { const int kb = r / 109, nb = r % 109; tr_item((const float*)args.in[I_WIN], INW, 64 * kb, 32 * nb, WIN, DM, win_drow(32 * nb), nullptr, 1.f, false, scr, lane); continue; } r -= I_IN;
            if (r < I_UQ) { const int kb = r / 24, nb = r % 24; tr_item((const float*)args.in[I_WUQ], QW, 64 * kb, 32 * nb, WUP, 256, 32 * nb, (const float*)args.in[I_QNG], C2, (nb % 3) == 2, scr, lane); continue; } r -= I_UQ;
            if (r < I_UKV) { const int kb = r / 32, nb = r % 32; tr_item((const float*)args.in[I_WUKV], 1024, 64 * kb, 32 * nb, WUP, 256, 768 + 32 * nb, (const float*)args.in[I_KVNG], 1.f, false, scr, lane); continue; } r -= I_UKV;
            if (r < 2 * I_BR) { const int br = r / I_BR, q = r % I_BR, kb = q / 32, nb = q % 32; tr_item((const float*)args.in[br ? I_WBRS : I_WBRM], DM, 64 * kb, 32 * nb, WBR, 512, br * 1024 + 32 * nb, nullptr, 1.f, false, scr, lane); continue; } r -= 2 * I_BR;
            if (r < I_OUT) { const int kb = r / 32, nb = r % 32; tr_item((const float*)args.in[I_WOUT], DM, 64 * kb, 32 * nb, WOUT, DM, 32 * nb, nullptr, 1.f, false, scr, lane); continue; } r -= I_OUT;
            const int e = r / (2 * I_E13 + I_E2); r %= (2 * I_E13 + I_E2);
            if (r < 2 * I_E13) { const int w3 = r / I_E13, q = r % I_E13, kb = q / 16, nb = q % 16, n0 = 32 * nb;
                tr_item((const float*)args.in[w3 ? I_W3 : I_W1] + (size_t)e * DM * EFF, EFF, 64 * kb, n0, W13, DM, e * 1024 + 256 * (n0 / 128) + 128 * w3 + (n0 % 128), nullptr, 1.f, false, scr, lane); continue; } r -= 2 * I_E13;
            { const int kb = r / 32, nb = r % 32; tr_item((const float*)args.in[I_W2] + (size_t)e * EFF * DM, DM, 64 * kb, 32 * nb, W2, EFF, e * 1024 + 32 * nb, nullptr, 1.f, false, scr, lane); }
        }
        for (int it = gw; it < 96 * 2 + 1024 / 4; it += NGW) {
            const u32x4 z = {0u, 0u, 0u, 0u};
            if (it < 192) { const int row = 416 + it / 2, c0 = (it & 1) * 512 + lane * 8; *(u32x4*)(WIN + (size_t)row * DM + c0) = z; }
            else { const int row = 768 + (it - 192) * 4 + (lane >> 4), c0 = 128 + (lane & 15) * 8; *(u32x4*)(WUP + (size_t)row * 256 + c0) = z; }
        }
        { const float* wada = (const float*)args.in[I_WADA]; const float* badA = (const float*)args.in[I_BADA]; const float* cvec = (const float*)args.in[I_C];
            LAS float* part = (LAS float*)(L + 8 * 16384);
            for (int cg = vcu; cg < 96; cg += G) { const int col = 64 * cg + lane; float s0 = 0.f, s1 = 0.f;
#pragma unroll
                for (int kk = 0; kk < 2; ++kk) { const int kb = 128 * wave + 64 * kk;
                    const float c0 = cvec[kb + lane], c1 = cvec[DM + kb + lane]; const float a0 = c0 * sigmoidf_(c0), a1 = c1 * sigmoidf_(c1);
#pragma unroll 16
                    for (int k = 0; k < 64; ++k) { const float w = wada[(size_t)(kb + k) * 6144 + col]; s0 += __shfl(a0, k) * w; s1 += __shfl(a1, k) * w; } }
                part[(wave * 2 + 0) * 64 + lane] = s0; part[(wave * 2 + 1) * 64 + lane] = s1;
                __syncthreads();
                if (tid < 128) { const int b = tid >> 6, l = tid & 63; float a = badA[64 * cg + l];
#pragma unroll
                    for (int w = 0; w < 8; ++w) a += part[(w * 2 + b) * 64 + l];
                    mod[b * 6144 + 64 * cg + l] = a; }
                __syncthreads(); } }
        { const int* pos = (const int*)args.in[I_POS]; f32x2* cs = (f32x2*)(ws + WS_CS);
            for (int it = gw * 64 + lane; it < NTOK * 16; it += NGW * 64) { const int tok = it >> 4, i = it & 15;
                const float freq = powf(10000.0f, -(float)i / 16.0f); const float ang = (float)pos[tok] * freq;
                const double rv = (double)ang * 0.15915494309189535; const float fr = (float)(rv - rint(rv));
                cs[it] = (f32x2){__builtin_amdgcn_cosf(fr), __builtin_amdgcn_sinf(fr)}; } }
        { const float* wsp = (const float*)args.in[I_WS]; bf16_t* wst = (bf16_t*)(ws + WS_WSTRIL);
            for (int it = gw * 64 + lane; it < 8 * 128 * 128; it += NGW * 64) { const int t = (it >> 7) & 127, s = it & 127; wst[it] = f2bf(s <= t ? wsp[it] : 0.f); } }
    }
    SEAM(0);

    if (IN(1)) {
        const int tid = opq(tid0), lane = tid & 63; (void)tid;
        bf16_t* XN = (bf16_t*)(ws + WS_XN); const float* g1 = (const float*)args.in[I_N1G];
        for (int m = gw; m < NTOK; m += NGW) { const float* md = mod + (m / SEQ) * 6144;
            const f32x4* xr = (const f32x4*)(x + (size_t)m * DM) + lane; f32x4 v[4]; float s = 0.f;
#pragma unroll
            for (int j = 0; j < 4; ++j) { v[j] = xr[64 * j]; s += (v[j][0] * v[j][0] + v[j][1] * v[j][1]) + (v[j][2] * v[j][2] + v[j][3] * v[j][3]); }
            const float rs = 1.0f / sqrtf(wave_sum(s) * (1.f / DM) + EPS);
            u32x2* o8 = (u32x2*)(XN + (size_t)m * DM) + lane;
#pragma unroll
            for (int j = 0; j < 4; ++j) { const int col = 256 * j + 4 * lane; const f32x4 gg = *(const f32x4*)(g1 + col), sc = *(const f32x4*)(md + 1024 + col), sh = *(const f32x4*)(md + col);
                const f32x4 h = v[j] * rs * gg * (sc + 1.0f) + sh; o8[64 * j] = (u32x2){pk2(h[0], h[1]), pk2(h[2], h[3])}; } }
    }
    SEAM(1);

    if (IN(2)) {
        pg8::Gemm g{(const bf16_t*)(ws + WS_XN), (const bf16_t*)(ws + WS_WIN), DM, DM};
        OrderGrid S; S.gm.init(NTOK / 256, NPROJ / 256); S.G = G; S.c = bx; S.split_pn = 1000; S.acol_hi = 0;
        EpiProj E{(bf16_t*)(ws + WS_CQKV), (bf16_t*)(ws + WS_SGUU), (bf16_t*)(ws + WS_SGUV), (bf16_t*)(ws + WS_GATES), ssqq, ssqkv};
        pg8::gemm_phase<EpiProj, OrderGrid, false>(L, g, S, E, nullptr);
    }
    SEAM(2);

    if (IN(3)) {
        const int tid = opq(tid0), lane = tid & 63; (void)tid;
        pg8::Gemm g{(const bf16_t*)(ws + WS_CQKV), (const bf16_t*)(ws + WS_WUP), 512, 256};
        OrderGrid S; S.gm.init(NTOK / 256, 7); S.G = G; S.c = bx; S.split_pn = 3; S.acol_hi = 256;
        EpiUp E{(bf16_t*)(ws + WS_Q), (bf16_t*)(ws + WS_KN), (bf16_t*)(ws + WS_V), ssqq, ssqkv, (const f32x4*)(ws + WS_CS)};
        pg8::gemm_phase<EpiUp, OrderGrid, false>(L, g, S, E, nullptr);
        { const bf16_t* cq = (const bf16_t*)(ws + WS_CQKV); bf16_t* kpe = (bf16_t*)(ws + WS_KPE); const f32x2* cs = (const f32x2*)(ws + WS_CS);
            for (int it = gw * 64 + lane; it < NTOK * 32; it += NGW * 64) { const int tok = it >> 5, p = it & 31, i = 4 * (p >> 3) + (p & 3), n = (p >> 2) & 1;
                const float x1 = bf2f(cq[(size_t)tok * 512 + 384 + i]), x2 = bf2f(cq[(size_t)tok * 512 + 384 + 16 + i]); const f32x2 c = cs[tok * 16 + i];
                kpe[it] = f2bf(n ? x1 * c[1] + x2 * c[0] : x1 * c[0] - x2 * c[1]); } }
    }
    SEAM(3);

    if (IN(4)) {
        const int bh = vcu >> 4, s = vcu & 15;
        for (int i = 0; i < 4; ++i) { const int qb = (i == 0) ? s : (i == 1) ? 31 - s : (i == 2) ? 32 + s : 63 - s;
            attn::attn_unit(bh >> 3, bh & 7, qb, (const bf16_t*)(ws + WS_Q), (const bf16_t*)(ws + WS_KN), (const bf16_t*)(ws + WS_KPE), (const bf16_t*)(ws + WS_V), (bf16_t*)(ws + WS_AO), (char*)lds); }
    }
    SEAM(4);

    if (IN(5)) {
        const int tid = opq(tid0), lane = tid & 63; (void)tid;
        const bf16_t* SV = (const bf16_t*)(ws + WS_SGUV); const bf16_t* SU = (const bf16_t*)(ws + WS_SGUU); bf16_t* SO = (bf16_t*)(ws + WS_SO);
        const bf16_t* wst = (const bf16_t*)(ws + WS_WSTRIL); const float* vng = (const float*)args.in[I_VNG]; const float* vnb = (const float*)args.in[I_VNB]; const float* bs = (const float*)args.in[I_BS];
        for (int ch = vcu; ch < NTOK / 128; ch += G) {
            const int tok0 = ch * 128;
            float gn[8], bn[8];
#pragma unroll
            for (int i = 0; i < 8; ++i) { gn[i] = vng[lane + 64 * i]; bn[i] = vnb[lane + 64 * i]; }
            for (int rr = 0; rr < 16; ++rr) { const int sp = wave * 16 + rr; const bf16_t* vr = SV + (size_t)(tok0 + sp) * 512; float xv[8]; float s = 0.f, s2 = 0.f;
#pragma unroll
                for (int i = 0; i < 8; ++i) { xv[i] = bf2f(vr[lane + 64 * i]); s += xv[i]; }
                const float mu = wave_sum(s) * (1.f / 512.f);
#pragma unroll
                for (int i = 0; i < 8; ++i) { xv[i] -= mu; s2 += xv[i] * xv[i]; }
                const float rstd = 1.0f / sqrtf(wave_sum(s2) * (1.f / 512.f) + EPS);
#pragma unroll
                for (int i = 0; i < 8; ++i) { const int c = lane + 64 * i; *(LAS bf16_t*)(L + c * 256 + ((((sp >> 3) ^ (c & 15)) << 4) | ((sp & 7) << 1))) = f2bf(xv[i] * rstd * gn[i] + bn[i]); } }
            __syncthreads();
            { const int g = wave, r32 = lane & 31, hh = lane >> 5; f32x16 acc[4][2];
#pragma unroll
                for (int tb = 0; tb < 4; ++tb) { acc[tb][0] = f32x16{}; acc[tb][1] = f32x16{}; }
#pragma unroll
                for (int tb = 0; tb < 4; ++tb)
#pragma unroll
                    for (int ks = 0; ks < 2 * tb + 2; ++ks) {
                        const bf16x8 a = *(const bf16x8*)(wst + (size_t)g * 16384 + (32 * tb + r32) * 128 + 16 * ks + 8 * hh);
#pragma unroll
                        for (int cb = 0; cb < 2; ++cb) { const int c = 64 * g + 32 * cb + r32;
                            const bf16x8 b = *(const LAS bf16x8*)(L + c * 256 + (((2 * ks + hh) ^ (c & 15)) << 4));
                            acc[tb][cb] = __builtin_amdgcn_mfma_f32_32x32x16_bf16(a, b, acc[tb][cb], 0, 0, 0); } }
#pragma unroll
                for (int tb = 0; tb < 4; ++tb)
#pragma unroll
                    for (int r = 0; r < 16; ++r) { const int t = 32 * tb + (r & 3) + 8 * (r >> 2) + 4 * hh; const float bb = bs[g * 128 + t];
#pragma unroll
                        for (int cb = 0; cb < 2; ++cb) { const size_t off = (size_t)(tok0 + t) * 512 + 64 * g + 32 * cb + r32; SO[off] = f2bf((acc[tb][cb][r] + bb) * bf2f(SU[off])); } }
            }
            __syncthreads();
        }
    }
    SEAM(5);

    if (IN(6)) {
        pg8::Gemm g{(const bf16_t*)(ws + WS_AO), (const bf16_t*)(ws + WS_WBR), 512, 512};
        struct OB2 { OrderBranch ob; long delta; __device__ __forceinline__ bool next(int i, Unit& u) const { if (!ob.next(i, u)) return false; u.acol = 0; if (u.e) u.arow += (int)delta; return true; } };
        OB2 S; S.ob.gm.init(NTOK / 256, 4); S.ob.G = G; S.ob.c = bx; S.delta = (long)((WS_SO - WS_AO) / (512 * 2));
        EpiBranch E{(const bf16_t*)(ws + WS_GATES), (bf16_t*)(ws + WS_MERGED)};
        pg8::gemm_phase<EpiBranch, OB2, false>(L, g, S, E, nullptr);
    }
    SEAM(6);

    if (IN(7)) {
        pg8::Gemm g{(const bf16_t*)(ws + WS_MERGED), (const bf16_t*)(ws + WS_WOUT), DM, DM};
        OrderGrid S; S.gm.init(NTOK / 256, 4); S.G = G; S.c = bx; S.split_pn = 1000; S.acol_hi = 0;
        EpiOut E{x, mod, out};
        pg8::gemm_phase<EpiOut, OrderGrid, false>(L, g, S, E, nullptr);
    }
    SEAM(7);

    if (IN(8)) {
        const int tid = opq(tid0), lane = tid & 63; (void)tid;
        bf16_t* H2 = (bf16_t*)(ws + WS_H2); const float* g2 = (const float*)args.in[I_N2G];
        const f32x4* wrg = (const f32x4*)args.in[I_WRG]; const float* brg = (const float*)args.in[I_BRG]; const f32x4* wre = (const f32x4*)args.in[I_WRE]; const float* bre = (const float*)args.in[I_BRE];
        unsigned* list = (unsigned*)(ws + WS_LIST); float* lw = (float*)(ws + WS_LW);
        for (int m = gw; m < NTOK; m += NGW) { const float* md = mod + (m / SEQ) * 6144;
            const f32x4* xr = (const f32x4*)(out + (size_t)m * DM) + lane; f32x4 v[4]; float s = 0.f;
#pragma unroll
            for (int j = 0; j < 4; ++j) { v[j] = xr[64 * j]; s += (v[j][0] * v[j][0] + v[j][1] * v[j][1]) + (v[j][2] * v[j][2] + v[j][3] * v[j][3]); }
            const float rs = 1.0f / sqrtf(wave_sum(s) * (1.f / DM) + EPS);
            u32x2* o8 = (u32x2*)(H2 + (size_t)m * DM) + lane; float gl[4] = {0.f, 0.f, 0.f, 0.f};
#pragma unroll
            for (int j = 0; j < 4; ++j) { const int col = 256 * j + 4 * lane; const f32x4 gg = *(const f32x4*)(g2 + col), sc = *(const f32x4*)(md + 4096 + col), sh = *(const f32x4*)(md + 3072 + col);
                v[j] = v[j] * rs * gg * (sc + 1.0f) + sh; o8[64 * j] = (u32x2){pk2(v[j][0], v[j][1]), pk2(v[j][2], v[j][3])};
#pragma unroll
                for (int i = 0; i < 4; ++i) { const f32x4 w = wrg[col + i];
#pragma unroll
                    for (int q = 0; q < 4; ++q) gl[q] += v[j][i] * w[q]; } }
#pragma unroll
            for (int q = 0; q < 4; ++q) gl[q] = wave_sum(gl[q]) + brg[q];
            int grp = 0; float gmax = gl[0];
#pragma unroll
            for (int q = 1; q < 4; ++q) if (gl[q] > gmax) { gmax = gl[q]; grp = q; }
            float gs = 0.f;
#pragma unroll
            for (int q = 0; q < 4; ++q) gs += expf(gl[q] - gmax);
            const float pgrp = 1.0f / gs;
            float el[8] = {0.f, 0.f, 0.f, 0.f, 0.f, 0.f, 0.f, 0.f};
#pragma unroll
            for (int j = 0; j < 4; ++j) { const int col = 256 * j + 4 * lane;
#pragma unroll
                for (int i = 0; i < 4; ++i) { const f32x4 w0 = wre[(size_t)(col + i) * 8 + 2 * grp], w1 = wre[(size_t)(col + i) * 8 + 2 * grp + 1];
#pragma unroll
                    for (int q = 0; q < 4; ++q) { el[q] += v[j][i] * w0[q]; el[4 + q] += v[j][i] * w1[q]; } } }
#pragma unroll
            for (int q = 0; q < 8; ++q) el[q] = wave_sum(el[q]) + bre[8 * grp + q];
            int i0 = 0; float m0 = el[0];
#pragma unroll
            for (int q = 1; q < 8; ++q) if (el[q] > m0) { m0 = el[q]; i0 = q; }
            int i1 = -1; float m1 = -INFINITY;
#pragma unroll
            for (int q = 0; q < 8; ++q) if (q != i0 && el[q] > m1) { m1 = el[q]; i1 = q; }
            const float d = expf(m1 - m0), t0 = 1.0f / (1.0f + d), t1 = d * t0;
            if (lane == 0) { const int e0 = 8 * grp + i0, e1 = 8 * grp + i1;
                const unsigned p0 = atomicAdd(ecnt + e0, 1u); list[(size_t)e0 * ECAP + p0] = 2u * m; lw[(size_t)e0 * ECAP + p0] = pgrp * t0;
                const unsigned p1 = atomicAdd(ecnt + e1, 1u); list[(size_t)e1 * ECAP + p1] = 2u * m + 1u; lw[(size_t)e1 * ECAP + p1] = pgrp * t1; }
        }
    }
    SEAM(8);

    if (IN(9) || IN(10)) {
        if (tid0 == 0) { unsigned acc = 0; for (int e = 0; e < NEXP; ++e) { MISC[16 + e] = acc; acc += (__hip_atomic_load(ecnt + e, RLX_AGENT) + 255u) >> 8; } MISC[16 + 32] = acc; MISC[16 + 33] = acc; }
        __syncthreads();
    }
    if (IN(9)) {
        const int tid = opq(tid0);
        OrderMoe S{MISC + 16, ecnt, G, bx};
        const unsigned* list = (const unsigned*)(ws + WS_LIST); LAS unsigned* tokl = (LAS unsigned*)(L + TOKL_OFF);
        { Unit u; for (int i = 0; i < MAXU && S.next(i, u); ++i) if (tid < 256) tokl[i * 256 + tid] = (tid < u.cnt) ? (list[(size_t)u.e * ECAP + u.aux * 256 + tid] >> 1) : 0u; }
        __syncthreads();
        pg8::Gemm g{(const bf16_t*)(ws + WS_H2), (const bf16_t*)(ws + WS_W13), DM, DM};
        EpiMoe1 E{(bf16_t*)(ws + WS_HM)};
        pg8::gemm_phase<EpiMoe1, OrderMoe, true>(L, g, S, E, tokl);
    }
    SEAM(9);
    if (IN(10)) {
        OrderMoe S{MISC + 16, ecnt, G, bx};
        pg8::Gemm g{(const bf16_t*)(ws + WS_HM), (const bf16_t*)(ws + WS_W2), EFF, EFF};
        EpiMoe2 E{(const unsigned*)(ws + WS_LIST), (const float*)(ws + WS_LW), (bf16_t*)(ws + WS_Y)};
        pg8::gemm_phase<EpiMoe2, OrderMoe, false>(L, g, S, E, nullptr);
    }
    SEAM(10);

    if (IN(11)) {
        const int tid = opq(tid0), lane = tid & 63; (void)tid;
        const bf16_t* Y = (const bf16_t*)(ws + WS_Y); const float* fg = (const float*)args.in[I_FG];
        for (int m = gw; m < NTOK; m += NGW) { const float* md = mod + (m / SEQ) * 6144 + 5120;
            f32x4* xr = (f32x4*)(out + (size_t)m * DM) + lane; const u32x2* y0 = (const u32x2*)(Y + (size_t)(2 * m) * DM) + lane; const u32x2* y1 = (const u32x2*)(Y + (size_t)(2 * m + 1) * DM) + lane;
            f32x4 v[4]; float s = 0.f;
#pragma unroll
            for (int j = 0; j < 4; ++j) { const int col = 256 * j + 4 * lane; const u32x2 a = y0[64 * j], b = y1[64 * j]; const f32x4 g2 = *(const f32x4*)(md + col);
                const f32x4 ys = {bflo(a.x) + bflo(b.x), bfhi(a.x) + bfhi(b.x), bflo(a.y) + bflo(b.y), bfhi(a.y) + bfhi(b.y)};
                v[j] = xr[64 * j] + g2 * ys; s += (v[j][0] * v[j][0] + v[j][1] * v[j][1]) + (v[j][2] * v[j][2] + v[j][3] * v[j][3]); }
            const float rs = 1.0f / sqrtf(wave_sum(s) * (1.f / DM) + EPS);
#pragma unroll
            for (int j = 0; j < 4; ++j) { const int col = 256 * j + 4 * lane; xr[64 * j] = v[j] * rs * *(const f32x4*)(fg + col); } }
    }
#undef IN
#undef SEAM
}

extern "C" void kernel_launch(void* const* d_in, const int* in_sizes, int n_in, void* d_out, int out_size, void* d_ws, size_t ws_size, hipStream_t stream) {
    static int grid = 0;
    if (grid == 0) {
        if (n_in != 27 || out_size != NTOK * DM || ws_size < WS_END) { fprintf(stderr, "kernel_launch: unexpected shapes (n_in %d, out %d, ws %zu)\n", n_in, out_size, ws_size); grid = -1; return; }
        int dev = 0, cus = 0;
        if (hipGetDevice(&dev) != hipSuccess || hipDeviceGetAttribute(&cus, hipDeviceAttributeMultiprocessorCount, dev) != hipSuccess) { grid = -1; return; }
        if (hipFuncSetAttribute((const void*)fwd_kernel, hipFuncAttributeMaxDynamicSharedMemorySize, LDS_BYTES) != hipSuccess) { fprintf(stderr, "kernel_launch: hipFuncSetAttribute failed\n"); grid = -1; return; }
        (void)hipGetLastError();
        grid = cus;
    }
    if (grid < 0) return;
    (void)hipMemsetAsync((char*)d_ws + WS_CTL, 0, CTL_ZERO_BYTES, stream);
    Args a{};
    for (int i = 0; i < 27; ++i) a.in[i] = d_in[i];
    a.out = (float*)d_out; a.ws = (unsigned char*)d_ws;
#if MK_ONE_LAUNCH
    a.ph_lo = 0; a.ph_hi = NPHASE;
    hipLaunchKernelGGL(fwd_kernel, dim3(grid), dim3(NWAVES * 64), LDS_BYTES, stream, a);
#else
    for (int p = 0; p < NPHASE; ++p) { a.ph_lo = p; a.ph_hi = p + 1; hipLaunchKernelGGL(fwd_kernel, dim3(grid), dim3(NWAVES * 64), LDS_BYTES, stream, a); }
#endif
}
```

```cpp
#include <hip/hip_runtime.h>
#include <hip/hip_bf16.h>
#include <cstdio>
#include <cstdint>
#include <cmath>

#ifndef MK_ONE_LAUNCH
#define MK_ONE_LAUNCH 1
#endif

#define LAS __attribute__((address_space(3)))
#define GAS __attribute__((address_space(1)))
typedef unsigned short bf16_t;
typedef short bf16x8 __attribute__((ext_vector_type(8)));
typedef short s16x4 __attribute__((ext_vector_type(4)));
typedef float f32x2 __attribute__((ext_vector_type(2)));
typedef float f32x4 __attribute__((ext_vector_type(4)));
typedef float f32x16 __attribute__((ext_vector_type(16)));
typedef unsigned u32x2 __attribute__((ext_vector_type(2)));
typedef unsigned u32x4 __attribute__((ext_vector_type(4)));
typedef __bf16 bf16x2_t __attribute__((ext_vector_type(2)));

__device__ __forceinline__ unsigned pk2(float lo, float hi) { f32x2 v = {lo, hi}; bf16x2_t b = __builtin_convertvector(v, bf16x2_t); return __builtin_bit_cast(unsigned, b); }
__device__ __forceinline__ float bflo(unsigned u) { return __uint_as_float(u << 16); }
__device__ __forceinline__ float bfhi(unsigned u) { return __uint_as_float(u & 0xffff0000u); }
__device__ __forceinline__ float bf2f(bf16_t h) { return __uint_as_float((unsigned)h << 16); }
__device__ __forceinline__ bf16_t f2bf(float f) { return (bf16_t)(pk2(f, 0.f) & 0xffffu); }
__device__ __forceinline__ float sigmoidf_(float x) { return __builtin_amdgcn_rcpf(1.0f + __builtin_amdgcn_exp2f(-1.4426950408889634f * x)); }
__device__ __forceinline__ float gelu_tanh(float x) { const float u = 0.7978845608028654f * (x + 0.044715f * x * x * x); return x * __builtin_amdgcn_rcpf(1.0f + __builtin_amdgcn_exp2f(-2.8853900817779268f * u)); }
#define DPPF(v, ctrl, rmask) __uint_as_float(__builtin_amdgcn_update_dpp(0u, __float_as_uint(v), ctrl, rmask, 0xF, false))
__device__ __forceinline__ float wave_sum(float v) {
    v += DPPF(v, 0xB1, 0xF);
    v += DPPF(v, 0x4E, 0xF);
    v += DPPF(v, 0x141, 0xF);
    v += DPPF(v, 0x140, 0xF);
    v += DPPF(v, 0x142, 0xA);
    v += DPPF(v, 0x143, 0xC);
    return __uint_as_float(__builtin_amdgcn_readlane(__float_as_uint(v), 63));
}
__device__ __forceinline__ int opq(int x) { asm volatile("" : "+v"(x)); return x; }
#define LDS_WAIT() asm volatile("s_waitcnt lgkmcnt(0)" ::: "memory")
#define VM_WAIT() asm volatile("s_waitcnt vmcnt(0)" ::: "memory")

constexpr int NB = 2, SEQ = 16384, NTOK = NB * SEQ, DM = 1024;
constexpr int NH = 8, DQK = 96, QW = NH * DQK  ;
constexpr int INW = 3488, NPROJ = 3584;
constexpr int NEXP = 32, EFF = 512, ECAP = 32768;
constexpr float EPS = 1e-6f;
constexpr float C2 = 0.10206207261596577f * 1.4426950408889634f;
constexpr int NWAVES = 8;
constexpr int W13_LATE = 384;

constexpr size_t MiB = 1u << 20;
constexpr size_t WS_CTL = 0, CTL_ZERO_BYTES = 1 * MiB;
constexpr int CW_TMO = 0, CW_BAR = 4096, CW_CNT = 8192;
constexpr size_t WS_MOD = 65536;
constexpr size_t WS_SSQQ = 2 * MiB, WS_SSQKV = 3 * MiB;
constexpr size_t WS_BIASP = 65536 + 49152;
constexpr size_t WS_WPH = 1 * MiB + 512 * 1024, WS_WPL = 1 * MiB + 768 * 1024;
constexpr size_t WS_WSTRIL = 1 * MiB;
constexpr size_t WS_CS = 4 * MiB;
constexpr size_t WS_LIST = 8 * MiB, WS_LW = 12 * MiB;
constexpr size_t WS_W13 = 16 * MiB, WS_W2 = 80 * MiB, WS_WIN = 112 * MiB, WS_WOUT = 119 * MiB, WS_WBR = 121 * MiB, WS_WUP = 123 * MiB;
constexpr size_t WS_GATES = 128 * MiB, WS_AS = 256 * MiB, WS_SGUV = 320 * MiB, WS_CQKV = 466 * MiB, WS_XN = 352 * MiB;
constexpr size_t WS_Q = 352 * MiB, WS_KN = 400 * MiB, WS_V = 432 * MiB, WS_KPE = 464 * MiB;
constexpr size_t WS_X1B = 416 * MiB;
constexpr size_t WS_MERGED = 352 * MiB, WS_H2 = 128 * MiB, WS_HM = 192 * MiB, WS_Y = 264 * MiB, WS_END = 512 * MiB;

constexpr int RING_BYTES = 131072;
constexpr int MISC_OFF = RING_BYTES;
constexpr int TOKL_OFF = RING_BYTES + 1024;
constexpr int MAXU = 6;
constexpr int LDS_BYTES = 147456;
static_assert(TOKL_OFF + MAXU * 1024 <= LDS_BYTES, "LDS map");

namespace pg8 {
constexpr int BM = 256, BK = 64, HALF = 128, HTB = HALF * BK * 2, STAGE_BYTES = 8 * HTB, NXCD = 8, WGM = 8;
__host__ __device__ __forceinline__ int lds_byte(int r, int c) { const int st = (r >> 4) * 2 + (c >> 5), rr = r & 15, cc = c & 31, ob = rr * 64 + cc * 2; return st * 1024 + (ob ^ (((ob >> 9) & 1) << 5)); }
__host__ __device__ __forceinline__ void stage_rc(int b, int& R, int& C) { const int st = b / 1024, sb = b % 1024, swz = sb ^ (((sb >> 9) & 1) << 5); R = (st >> 1) * 16 + swz / 64; C = (st & 1) * 32 + (swz % 64) / 2; }
__host__ __device__ __forceinline__ int perm32(int rho) { const int n = rho >> 4, i = rho & 15; return 8 * (i >> 2) + 4 * n + (i & 3); }

struct Unit { int arow, acol, brow, pm, pn, e, cnt, aux; };
struct Gemm { const bf16_t* A; const bf16_t* Bt; int lda, K; };

struct GridMap {
    int nM, nN, nwg;
    __device__ __forceinline__ void init(int nM_, int nN_) { nM = nM_; nN = nN_; nwg = nM_ * nN_; }
    __device__ __forceinline__ bool map(long L, int& pm, int& pn) const {
        if (L >= nwg) return false;
        int wgid = (int)L; { const int q = nwg / NXCD, r = nwg % NXCD, xcd = wgid % NXCD, off = wgid / NXCD; wgid = (xcd < r ? xcd * (q + 1) : r * (q + 1) + (xcd - r) * q) + off; }
        const int nig = WGM * nN, gid = wgid / nig, fm = gid * WGM, gsz = (nM - fm) < WGM ? (nM - fm) : WGM;
        pm = fm + ((wgid % nig) % gsz); pn = (wgid % nig) / gsz; return true;
    }
};

template <class Epi, class Sched, bool GATHER>
__device__ __forceinline__ void gemm_phase(LAS unsigned char* lds, const Gemm g, const Sched& S, const Epi& E, const LAS unsigned* tokl) {
    const int tid = opq(threadIdx.x), wid = __builtin_amdgcn_readfirstlane(tid >> 6), lane = tid & 63, wr = wid >> 2, wc = wid & 3, fr = lane & 15, fq = lane >> 4;
    const int K = g.K, nt = K / BK, lda = g.lda;
    unsigned voffB[2], vA0c[2], vA1c[2], vA0n[2], vA1n[2]; int Rr[2]; unsigned Cb[2];
#pragma unroll
    for (int i = 0; i < 2; ++i) { int R, C; stage_rc(tid * 16 + i * 8192, R, C); const int Rb = Epi::PERM ? ((R & ~31) + perm32(R & 31)) : R;
        voffB[i] = (unsigned)(Rb * K + C) * 2u; Rr[i] = R; Cb[i] = (unsigned)C * 2u;
        vA0c[i] = (unsigned)(R * lda + C) * 2u; vA1c[i] = vA0c[i] + (unsigned)(HALF * lda) * 2u; vA0n[i] = vA0c[i]; vA1n[i] = vA1c[i]; }
    const size_t kstep = (size_t)(BK * 2);
    const size_t hstepB = (size_t)HALF * K * 2;
    const unsigned ldsw = (unsigned)wid * 1024u;
    const int aoff = lds_byte(wr * 64 + fr, fq * 8), boff = lds_byte(wc * 32 + fr, fq * 8);
#define PG8_SA(b, h) (((b) * 2 + (h)) * HTB)
#define PG8_SB(b, h) ((4 + (b) * 2 + (h)) * HTB)
#define PG8_STAGE(bufoff, gbase, voff) do { _Pragma("unroll") for (int _i = 0; _i < 2; ++_i) \
        __builtin_amdgcn_global_load_lds((const unsigned*)((const char*)(gbase) + (voff)[_i]), (LAS unsigned*)(lds + (bufoff) + ldsw + _i * 8192), 16, 0, 0); } while (0)
#define PG8_LDA(dst, b, h) do { _Pragma("unroll") for (int m = 0; m < 4; ++m) _Pragma("unroll") for (int k = 0; k < 2; ++k) dst[m][k] = *(const LAS bf16x8*)(lds + PG8_SA(b, h) + aoff + m * 2048 + k * 1024); } while (0)
#define PG8_LDB(dst, b, h) do { _Pragma("unroll") for (int n = 0; n < 2; ++n) _Pragma("unroll") for (int k = 0; k < 2; ++k) dst[n][k] = *(const LAS bf16x8*)(lds + PG8_SB(b, h) + boff + n * 2048 + k * 1024); } while (0)
#define PG8_MMA(ai, bj, At, Bt) do { __builtin_amdgcn_s_setprio(1); _Pragma("unroll") for (int m = 0; m < 4; ++m) _Pragma("unroll") for (int n = 0; n < 2; ++n) _Pragma("unroll") for (int k = 0; k < 2; ++k) \
        acc[ai][bj][m][n] = __builtin_amdgcn_mfma_f32_16x16x32_bf16(Bt[n][k], At[m][k], acc[ai][bj][m][n], 0, 0, 0); __builtin_amdgcn_s_setprio(0); } while (0)
#define PG8_WAIT_V(n) asm volatile("s_waitcnt vmcnt(" #n ")" ::: "memory")
#define PG8_WAIT_L(n) asm volatile("s_waitcnt lgkmcnt(" #n ")" ::: "memory")
#define PG8_BAR __builtin_amdgcn_s_barrier()
#define PG8_SCHED __builtin_amdgcn_sched_barrier(0)
    Unit cur, nxt; int ui = 0;
    if (!S.next(0, cur)) return;
    f32x4 acc[2][2][4][2];
#pragma unroll
    for (int a = 0; a < 2; ++a)
#pragma unroll
        for (int b = 0; b < 2; ++b)
#pragma unroll
            for (int m = 0; m < 4; ++m)
#pragma unroll
                for (int n = 0; n < 2; ++n) acc[a][b][m][n] = (f32x4){0.f, 0.f, 0.f, 0.f};
    bf16x8 At[4][2], B0[2][2], B1[2][2];
    if constexpr (GATHER) {
#pragma unroll
        for (int i = 0; i < 2; ++i) { vA0c[i] = tokl[Rr[i]] * (unsigned)(lda * 2) + Cb[i]; vA1c[i] = tokl[HALF + Rr[i]] * (unsigned)(lda * 2) + Cb[i]; }
    }
    const char* cA = GATHER ? (const char*)g.A : (const char*)g.A + ((size_t)cur.arow * lda + cur.acol) * 2;
    const char* cB = (const char*)g.Bt + (size_t)cur.brow * K * 2;
    PG8_STAGE(PG8_SB(0, 0), cB, voffB); PG8_STAGE(PG8_SB(0, 1), cB + hstepB, voffB); PG8_STAGE(PG8_SA(0, 0), cA, vA0c); PG8_STAGE(PG8_SA(0, 1), cA, vA1c);
    if (wr == 1) PG8_BAR;
    PG8_WAIT_V(2); PG8_BAR;
    PG8_STAGE(PG8_SB(1, 0), cB + kstep, voffB); PG8_STAGE(PG8_SA(1, 0), cA + kstep, vA0c); PG8_STAGE(PG8_SB(1, 1), cB + hstepB + kstep, voffB);
    PG8_WAIT_V(6); PG8_BAR;
    for (;;) {
        const bool has_next = S.next(ui + 1, nxt);
        const char* nA = cA; const char* nB = cB;
        if (has_next) { nA = GATHER ? (const char*)g.A : (const char*)g.A + ((size_t)nxt.arow * lda + nxt.acol) * 2; nB = (const char*)g.Bt + (size_t)nxt.brow * K * 2; }
        if constexpr (GATHER) {
            if (has_next) {
#pragma unroll
                for (int i = 0; i < 2; ++i) { vA0n[i] = tokl[(ui + 1) * 256 + Rr[i]] * (unsigned)(lda * 2) + Cb[i]; vA1n[i] = tokl[(ui + 1) * 256 + HALF + Rr[i]] * (unsigned)(lda * 2) + Cb[i]; }
            } else {
#pragma unroll
                for (int i = 0; i < 2; ++i) { vA0n[i] = vA0c[i]; vA1n[i] = vA1c[i]; }
            }
        }
#pragma unroll 1
        for (int t = 0; t < nt; t += 2) {
            const bool last = (t == nt - 2);
            if constexpr (Epi::HAS_MID) { if (t == (nt >> 1)) E.mid(acc, cur, wr, wc, fr, fq); }
            const char* a1 = cA + (size_t)(t + 1) * kstep;
            const char* a2 = last ? nA : cA + (size_t)(t + 2) * kstep; const char* b2 = last ? nB : cB + (size_t)(t + 2) * kstep;
            const char* a3 = a2 + kstep; const char* b3 = b2 + kstep;
            unsigned s0[2], s1[2];
#pragma unroll
            for (int i = 0; i < 2; ++i) { s0[i] = (GATHER && last) ? vA0n[i] : vA0c[i]; s1[i] = (GATHER && last) ? vA1n[i] : vA1c[i]; }
            PG8_LDB(B0, 0, 0); PG8_LDB(B1, 0, 1); PG8_SCHED; PG8_LDA(At, 0, 0); PG8_STAGE(PG8_SA(1, 1), a1, vA1c);
            PG8_WAIT_V(8); PG8_WAIT_L(0); PG8_BAR; PG8_MMA(0, 0, At, B0); PG8_MMA(0, 1, At, B1); PG8_BAR; PG8_SCHED;
            PG8_LDA(At, 0, 1); PG8_STAGE(PG8_SB(0, 0), b2, voffB); PG8_STAGE(PG8_SB(0, 1), b2 + hstepB, voffB); PG8_STAGE(PG8_SA(0, 0), a2, s0);
            PG8_WAIT_V(8); PG8_WAIT_L(0); PG8_BAR; PG8_MMA(1, 0, At, B0); PG8_MMA(1, 1, At, B1); PG8_BAR; PG8_SCHED;
            PG8_LDB(B0, 1, 0); PG8_LDB(B1, 1, 1); PG8_SCHED; PG8_LDA(At, 1, 0); PG8_STAGE(PG8_SA(0, 1), a2, s1);
            PG8_WAIT_V(8); PG8_WAIT_L(0); PG8_BAR; PG8_MMA(0, 0, At, B0); PG8_MMA(0, 1, At, B1); PG8_BAR; PG8_SCHED;
            PG8_LDA(At, 1, 1); PG8_STAGE(PG8_SB(1, 0), b3, voffB); PG8_STAGE(PG8_SB(1, 1), b3 + hstepB, voffB); PG8_STAGE(PG8_SA(1, 0), a3, s0);
            PG8_WAIT_V(8); PG8_WAIT_L(0); PG8_BAR; PG8_MMA(1, 0, At, B0); PG8_MMA(1, 1, At, B1); PG8_BAR; PG8_SCHED;
        }
        if (wr == 0) PG8_BAR;
        E(acc, cur, wr, wc, fr, fq);
        if (!has_next) break;
#pragma unroll
        for (int a = 0; a < 2; ++a)
#pragma unroll
            for (int b = 0; b < 2; ++b)
#pragma unroll
                for (int m = 0; m < 4; ++m)
#pragma unroll
                    for (int n = 0; n < 2; ++n) acc[a][b][m][n] = (f32x4){0.f, 0.f, 0.f, 0.f};
        cur = nxt; cA = nA; cB = nB; ++ui;
        if constexpr (GATHER) {
#pragma unroll
            for (int i = 0; i < 2; ++i) { vA0c[i] = vA0n[i]; vA1c[i] = vA1n[i]; }
        }
        if (wr == 1) PG8_BAR;
    }
    PG8_WAIT_V(0);
    PG8_BAR;
#undef PG8_SA
#undef PG8_SB
#undef PG8_STAGE
#undef PG8_LDA
#undef PG8_LDB
#undef PG8_MMA
#undef PG8_WAIT_V
#undef PG8_WAIT_L
#undef PG8_BAR
#undef PG8_SCHED
}
}
using pg8::Unit;

__device__ __forceinline__ u32x4 pack8(const f32x4& a, const f32x4& b) { u32x4 w; w.x = pk2(a[0], a[1]); w.y = pk2(a[2], a[3]); w.z = pk2(b[0], b[1]); w.w = pk2(b[2], b[3]); return w; }

struct EpiProj {
    static constexpr bool PERM = true, HAS_MID = false;
    bf16_t *cqkv, *as_u, *sguv, *gates; float *ssqq, *ssqkv;
    __device__ __forceinline__ void operator()(const f32x4 (&acc)[2][2][4][2], const Unit& u, int wr, int wc, int fr, int fq) const {
        fr = opq(fr); fq = opq(fq);
        const int pn = u.pn, row0 = u.pm * 256 + wr * 64 + fr;
        if (pn >= 6) {
            const int col = 128 * (pn - 6) + 32 * wc + 8 * fq;
#pragma unroll
            for (int ai = 0; ai < 2; ++ai)
#pragma unroll
                for (int m = 0; m < 4; ++m) { f32x4 r0, r1, s0, s1;
#pragma unroll
                    for (int j = 0; j < 4; ++j) { const float ea0 = __builtin_amdgcn_exp2f(-1.4426950408889634f * __builtin_amdgcn_fmed3f(acc[ai][0][m][0][j], -60.f, 60.f)), eb0 = __builtin_amdgcn_exp2f(-1.4426950408889634f * __builtin_amdgcn_fmed3f(acc[ai][1][m][0][j], -60.f, 60.f));
                        const float ea1 = __builtin_amdgcn_exp2f(-1.4426950408889634f * __builtin_amdgcn_fmed3f(acc[ai][0][m][1][j], -60.f, 60.f)), eb1 = __builtin_amdgcn_exp2f(-1.4426950408889634f * __builtin_amdgcn_fmed3f(acc[ai][1][m][1][j], -60.f, 60.f));
                        s0[j] = __builtin_amdgcn_rcpf(1.0f + eb0); s1[j] = __builtin_amdgcn_rcpf(1.0f + eb1);
                        r0[j] = (1.0f + eb0) * __builtin_amdgcn_rcpf(1.0f + ea0); r1[j] = (1.0f + eb1) * __builtin_amdgcn_rcpf(1.0f + ea1); }
                    bf16_t* rowp = gates + (size_t)(row0 + ai * 128 + m * 16) * 2048 + col;
                    *(u32x4*)rowp = pack8(r0, r1); *(u32x4*)(rowp + 1024) = pack8(s0, s1); }
            return;
        }
        bf16_t* base; int ld, act, colt;
        if (pn < 2) { base = cqkv; ld = 512; act = 0; colt = pn * 256; }
        else if (pn < 4) { base = as_u; ld = 1024; act = 1; colt = (pn - 2) * 256; }
        else { base = sguv; ld = 512; act = 1; colt = (pn - 4) * 256; }
        const int col0 = colt + wc * 32 + 8 * fq;
#pragma unroll
        for (int ai = 0; ai < 2; ++ai)
#pragma unroll
            for (int m = 0; m < 4; ++m) {
                const int row = row0 + ai * 128 + m * 16; bf16_t* rowp = base + (size_t)row * ld + col0; float ss = 0.f;
#pragma unroll
                for (int bj = 0; bj < 2; ++bj) { f32x4 v0 = acc[ai][bj][m][0], v1 = acc[ai][bj][m][1];
                    if (act == 0) { if (pn == 0 || bj == 0) ss += (v0[0] * v0[0] + v0[1] * v0[1]) + (v0[2] * v0[2] + v0[3] * v0[3]) + (v1[0] * v1[0] + v1[1] * v1[1]) + (v1[2] * v1[2] + v1[3] * v1[3]); }
                    else {
#pragma unroll
                        for (int j = 0; j < 4; ++j) { v0[j] = gelu_tanh(v0[j]); v1[j] = gelu_tanh(v1[j]); } }
                    *(u32x4*)(rowp + bj * 128) = pack8(v0, v1); }
                if (pn < 2) { ss += __shfl_xor(ss, 16); ss += __shfl_xor(ss, 32);
                    if (fq == 0) (pn == 0 ? ssqq : ssqkv)[(size_t)row * 4 + wc] = ss; }
            }
    }
};

struct EpiUp {
    static constexpr bool PERM = true, HAS_MID = false;
    bf16_t *q, *kn, *v; const float *ssqq, *ssqkv; const f32x4* cs;
    __device__ __forceinline__ void operator()(const f32x4 (&acc)[2][2][4][2], const Unit& u, int wr, int wc, int fr, int fq) const {
        fr = opq(fr); fq = opq(fq);
        const int pn = u.pn, row0 = u.pm * 256 + wr * 64 + fr;
#pragma unroll
        for (int ai = 0; ai < 2; ++ai)
#pragma unroll
            for (int m = 0; m < 4; ++m) {
                const int row = row0 + ai * 128 + m * 16;
                if (pn < 3) {
                    const f32x4 sp = *(const f32x4*)(ssqq + (size_t)row * 4); const float rs = 1.0f / sqrtf(((sp[0] + sp[1]) + (sp[2] + sp[3])) * (1.0f / 256.0f) + EPS);
#pragma unroll
                    for (int bj = 0; bj < 2; ++bj) { const int gg = 8 * pn + 4 * bj + wc, col = 256 * pn + 128 * bj + 32 * wc + 8 * fq;
                        f32x4 v0 = acc[ai][bj][m][0] * rs, v1 = acc[ai][bj][m][1] * rs;
                        if (gg % 3 == 2) { const f32x4 c01 = cs[(size_t)row * 8 + 2 * fq], c23 = cs[(size_t)row * 8 + 2 * fq + 1];
                            const float cc[4] = {c01[0], c01[2], c23[0], c23[2]}, sn[4] = {c01[1], c01[3], c23[1], c23[3]};
#pragma unroll
                            for (int j = 0; j < 4; ++j) { const float x1 = v0[j], x2 = v1[j]; v0[j] = x1 * cc[j] - x2 * sn[j]; v1[j] = x1 * sn[j] + x2 * cc[j]; } }
                        *(u32x4*)(q + (size_t)row * QW + col) = pack8(v0, v1); }
                } else {
                    const f32x4 sp = *(const f32x4*)(ssqkv + (size_t)row * 4); const float rs = 1.0f / sqrtf(((sp[0] + sp[1]) + (sp[2] + sp[3])) * (1.0f / 128.0f) + EPS);
#pragma unroll
                    for (int bj = 0; bj < 2; ++bj) { const int h = 2 * (pn - 3) + bj, cc = 32 * wc + 8 * fq;
                        bf16_t* dst = (wc < 2) ? kn + (size_t)row * 512 + h * 64 + cc : v + (size_t)row * 512 + h * 64 + cc - 64;
                        *(u32x4*)dst = pack8(acc[ai][bj][m][0] * rs, acc[ai][bj][m][1] * rs); }
                }

            }
    }
};

struct EpiBranch {
    static constexpr bool PERM = true, HAS_MID = true;
    const bf16_t* gates; bf16_t* merged;
    __device__ __forceinline__ void scale(f32x4 (&acc)[2][2][4][2], const Unit& u, int wr, int wc, int fr, int fq, int goff) const {
        const int row0 = u.pm * 256 + wr * 64 + fr;
#pragma unroll
        for (int ai = 0; ai < 2; ++ai)
#pragma unroll
            for (int m = 0; m < 4; ++m) { const int row = row0 + ai * 128 + m * 16;
#pragma unroll
                for (int bj = 0; bj < 2; ++bj) { const int col = 256 * u.pn + 128 * bj + 32 * wc + 8 * fq;
                    const u32x4 gw = *(const u32x4*)(gates + (size_t)row * 2048 + goff + col);
                    f32x4& v0 = acc[ai][bj][m][0]; f32x4& v1 = acc[ai][bj][m][1];
                    v0[0] *= bflo(gw.x); v0[1] *= bfhi(gw.x); v0[2] *= bflo(gw.y); v0[3] *= bfhi(gw.y); v1[0] *= bflo(gw.z); v1[1] *= bfhi(gw.z); v1[2] *= bflo(gw.w); v1[3] *= bfhi(gw.w); } }
    }
    __device__ __forceinline__ void mid(f32x4 (&acc)[2][2][4][2], const Unit& u, int wr, int wc, int fr, int fq) const { fr = opq(fr); fq = opq(fq); scale(acc, u, wr, wc, fr, fq, 0); }
    __device__ __forceinline__ void operator()(f32x4 (&acc)[2][2][4][2], const Unit& u, int wr, int wc, int fr, int fq) const {
        fr = opq(fr); fq = opq(fq);
        scale(acc, u, wr, wc, fr, fq, 1024);
        const int row0 = u.pm * 256 + wr * 64 + fr;
#pragma unroll
        for (int ai = 0; ai < 2; ++ai)
#pragma unroll
            for (int m = 0; m < 4; ++m) { const int row = row0 + ai * 128 + m * 16;
#pragma unroll
                for (int bj = 0; bj < 2; ++bj) *(u32x4*)(merged + (size_t)row * 1024 + 256 * u.pn + 128 * bj + 32 * wc + 8 * fq) = pack8(acc[ai][bj][m][0], acc[ai][bj][m][1]); }
    }
};

struct EpiOut {
    static constexpr bool PERM = true, HAS_MID = false;
    const float* x; const float* mod; bf16_t* x1b;
    __device__ __forceinline__ void operator()(const f32x4 (&acc)[2][2][4][2], const Unit& u, int wr, int wc, int fr, int fq) const {
        fr = opq(fr); fq = opq(fq);
        const int row0 = u.pm * 256 + wr * 64 + fr, col0 = u.pn * 256 + wc * 32 + 8 * fq; const float* g1 = mod + (u.pm >> 6) * 6144 + 2048;
        f32x4 gv[2][2];
#pragma unroll
        for (int bj = 0; bj < 2; ++bj)
#pragma unroll
            for (int n = 0; n < 2; ++n) gv[bj][n] = *(const f32x4*)(g1 + col0 + bj * 128 + n * 4);
#pragma unroll
        for (int ai = 0; ai < 2; ++ai)
#pragma unroll
            for (int m = 0; m < 4; ++m) { const size_t off = (size_t)(row0 + ai * 128 + m * 16) * DM + col0;
#pragma unroll
                for (int bj = 0; bj < 2; ++bj) { const f32x4 x0 = *(const f32x4*)(x + off + bj * 128), x1 = *(const f32x4*)(x + off + bj * 128 + 4);
                    *(u32x4*)(x1b + off + bj * 128) = pack8(x0 + gv[bj][0] * acc[ai][bj][m][0], x1 + gv[bj][1] * acc[ai][bj][m][1]); }
                 }
    }
};

struct EpiMoe1 {
    static constexpr bool PERM = true, HAS_MID = false;
    bf16_t* hm;
    __device__ __forceinline__ void operator()(const f32x4 (&acc)[2][2][4][2], const Unit& u, int wr, int wc, int fr, int fq) const {
        fr = opq(fr); fq = opq(fq);
        const int row0 = u.pm * 256 + wr * 64 + fr, col = 128 * u.pn + 32 * wc + 8 * fq;
#pragma unroll
        for (int ai = 0; ai < 2; ++ai)
#pragma unroll
            for (int m = 0; m < 4; ++m) { f32x4 h0, h1;
#pragma unroll
                for (int j = 0; j < 4; ++j) { const float a0 = acc[ai][0][m][0][j], a1 = acc[ai][0][m][1][j]; h0[j] = a0 * sigmoidf_(a0) * acc[ai][1][m][0][j]; h1[j] = a1 * sigmoidf_(a1) * acc[ai][1][m][1][j]; }
                *(u32x4*)(hm + (size_t)(row0 + ai * 128 + m * 16) * EFF + col) = pack8(h0, h1); }
    }
};

struct EpiMoe2 {
    static constexpr bool PERM = true, HAS_MID = false;
    const unsigned* list; const float* lw; bf16_t* y;
    __device__ __forceinline__ void operator()(const f32x4 (&acc)[2][2][4][2], const Unit& u, int wr, int wc, int fr, int fq) const {
        fr = opq(fr); fq = opq(fq);
#pragma unroll
        for (int ai = 0; ai < 2; ++ai)
#pragma unroll
            for (int m = 0; m < 4; ++m) { const int r = ai * 128 + wr * 64 + m * 16 + fr;
                if (r < u.cnt) { const size_t idx = (size_t)u.e * ECAP + u.aux * 256 + r; const unsigned tk = list[idx]; const float w = lw[idx];
#pragma unroll
                    for (int bj = 0; bj < 2; ++bj) *(u32x4*)(y + (size_t)tk * DM + 256 * u.pn + 128 * bj + 32 * wc + 8 * fq) = pack8(acc[ai][bj][m][0] * w, acc[ai][bj][m][1] * w); }
                 }
    }
};

struct OrderGrid {
    pg8::GridMap gm; int G, c, split_pn, acol_hi;
    __device__ __forceinline__ bool next(int i, Unit& u) const { int pm, pn; if (!gm.map((long)i * G + c, pm, pn)) return false;
        u.pm = pm; u.pn = pn; u.arow = pm * 256; u.acol = (pn >= split_pn) ? acol_hi : 0; u.brow = pn * 256; u.e = 0; u.cnt = 256; u.aux = 0; return true; }
};
struct OrderBranch {
    pg8::GridMap gm; int G, c;
    __device__ __forceinline__ bool next(int i, Unit& u) const { int pm, pn; if (!gm.map((long)(i >> 1) * G + c, pm, pn)) return false; const int br = i & 1;
        u.pm = pm; u.pn = pn; u.arow = pm * 256; u.acol = br * 512; u.brow = br * 1024 + pn * 256; u.e = br; u.cnt = 256; u.aux = 0; return true; }
};
struct OrderMoe {
    const volatile LAS unsigned* tp; const unsigned* cnt; int G, c;
    __device__ __forceinline__ bool next(int i, Unit& u) const {
        const int T = (int)tp[33], nwg = 4 * T; const long L = (long)i * G + c; if (L >= nwg) return false;
        int wgid = (int)L; { const int q = nwg / 8, r = nwg % 8, xcd = wgid % 8, off = wgid / 8; wgid = (xcd < r ? xcd * (q + 1) : r * (q + 1) + (xcd - r) * q) + off; }
        const int ti = wgid >> 2, pn = wgid & 3; int e = 0;
        for (int j = 1; j < NEXP; ++j) if ((int)tp[j] <= ti) e = j;
        const int tile = ti - (int)tp[e]; int rem = (int)__hip_atomic_load(cnt + e * 64, __ATOMIC_RELAXED, __HIP_MEMORY_SCOPE_AGENT) - tile * 256; rem = rem > 256 ? 256 : rem;
        u.pm = ti; u.pn = pn; u.arow = ti * 256; u.acol = 0; u.brow = e * 1024 + pn * 256; u.e = e; u.cnt = rem; u.aux = tile; return true; }
};

namespace attn {
#define SBAR() __builtin_amdgcn_sched_barrier(0)
__device__ __forceinline__ int crow(int r, int hi) { return (r & 3) + 8 * (r >> 2) + 4 * hi; }
constexpr int KSLOT = 12288, VSLOT = 8192;
constexpr int LDS_K = 0, LDS_V = 2 * KSLOT, LDS_WS = LDS_V + 2 * VSLOT, LDS_OST = LDS_WS + NWAVES * 64 * 4, LDS_END = LDS_OST + NWAVES * 4096;
static_assert(LDS_END <= RING_BYTES, "attention LDS");
__device__ __forceinline__ void glds16(const void* gsrc, unsigned lds_dst) { unsigned keep;
    asm volatile("s_mov_b32 %0, m0\n\ts_mov_b32 m0, %2\n\ts_nop 0\n\tglobal_load_lds_dwordx4 %1, off\n\ts_mov_b32 m0, %0" : "=&s"(keep) : "v"(gsrc), "s"(lds_dst) : "memory"); }
__device__ __forceinline__ void cmask(f32x16& p0, f32x16& p1, int jb, int qrel, int hi) {
    const float NEG = -INFINITY; const int kb = 64 * jb + 4 * hi;
#pragma unroll
    for (int r = 0; r < 16; ++r) { const int kv = kb + (r & 3) + 8 * (r >> 2); if (kv > qrel) p0[r] = NEG; if (kv + 32 > qrel) p1[r] = NEG; }
}
__device__ __forceinline__ void qkt(f32x16& p0, f32x16& p1, const char* Kslot, const bf16x8* qr, int r32, int hi) {
    const char* kb = Kslot + hi * 1024 + r32 * 16;
    p0 = f32x16{}; p1 = f32x16{};
#pragma unroll
    for (int d0 = 0; d0 < 6; ++d0) {
        const bf16x8 b0 = *reinterpret_cast<const bf16x8*>(kb + d0 * 2048);
        const bf16x8 b1 = *reinterpret_cast<const bf16x8*>(kb + d0 * 2048 + 512);
        p0 = __builtin_amdgcn_mfma_f32_32x32x16_bf16(b0, qr[d0], p0, 0, 0, 0); p1 = __builtin_amdgcn_mfma_f32_32x32x16_bf16(b1, qr[d0], p1, 0, 0, 0); }
}
__device__ __forceinline__ void pv(f32x16* o, int vb, bf16x8 pa0, bf16x8 pa1, bf16x8 pa2, bf16x8 pa3) {
#pragma unroll
    for (int d0 = 0; d0 < 2; ++d0) { s16x4 lo[4], hi[4];
#pragma unroll
        for (int ks = 0; ks < 4; ++ks) {
            asm volatile("ds_read_b64_tr_b16 %0,%1 offset:%c2" : "=&v"(lo[ks]) : "v"(vb), "i"(d0 * 4096 + ks * 1024) : "memory");
            asm volatile("ds_read_b64_tr_b16 %0,%1 offset:%c2" : "=&v"(hi[ks]) : "v"(vb), "i"(d0 * 4096 + ks * 1024 + 512) : "memory"); }
        asm volatile("s_waitcnt lgkmcnt(0)" ::: "memory"); SBAR();
#define PK(k) (bf16x8){lo[k][0], lo[k][1], lo[k][2], lo[k][3], hi[k][0], hi[k][1], hi[k][2], hi[k][3]}
        o[d0] = __builtin_amdgcn_mfma_f32_32x32x16_bf16(pa0, PK(0), o[d0], 0, 0, 0);
        o[d0] = __builtin_amdgcn_mfma_f32_32x32x16_bf16(pa1, PK(1), o[d0], 0, 0, 0);
        o[d0] = __builtin_amdgcn_mfma_f32_32x32x16_bf16(pa2, PK(2), o[d0], 0, 0, 0);
        o[d0] = __builtin_amdgcn_mfma_f32_32x32x16_bf16(pa3, PK(3), o[d0], 0, 0, 0);
#undef PK
    }
}
constexpr int NKS = 4, NVS = 3;
constexpr int P_K = 0, P_V = NKS * KSLOT, P_WS = P_V + NVS * VSLOT, P_OST = P_WS + NWAVES * 64 * 4, P_END = P_OST + NWAVES * 4096;
static_assert(P_END <= RING_BYTES, "attention LDS");
typedef __attribute__((address_space(3))) const char* lds_cptr;
typedef short v4i16_t __attribute__((ext_vector_type(4)));
__device__ __forceinline__ float max3f(float a, float b, float c) { float r; asm("v_max3_f32 %0, %1, %2, %3" : "=v"(r) : "v"(a), "v"(b), "v"(c)); return r; }
__device__ __forceinline__ float max2f(float a, float b) { float r; asm("v_max_f32_e32 %0, %1, %2" : "=v"(r) : "v"(a), "v"(b)); return r; }
__device__ __forceinline__ float fadd_s(float a, float b) { float r; asm("v_add_f32_e32 %0, %1, %2" : "=v"(r) : "v"(a), "v"(b)); return r; }
__device__ __forceinline__ float fsub_s(float a, float b) { float r; asm("v_sub_f32_e32 %0, %1, %2" : "=v"(r) : "v"(a), "v"(b)); return r; }
#define WAIT_BAR(N) asm volatile("s_waitcnt vmcnt(" #N ") lgkmcnt(0)\n\ts_barrier" ::: "memory")
#define WB3() do { if (lowh) { WAIT_BAR(3); } else { WAIT_BAR(2); } } while (0)
__device__ __forceinline__ bf16x8 kld(lds_cptr p) { return *(const __attribute__((address_space(3))) bf16x8*)p; }
__device__ __forceinline__ void kload2(bf16x8* kf, lds_cptr kp, int j) { kf[2 * j] = kld(kp + j * 2048); kf[2 * j + 1] = kld(kp + j * 2048 + 512); }
__device__ __forceinline__ s16x4 vtr(lds_cptr p) { return __builtin_bit_cast(s16x4, __builtin_amdgcn_ds_read_tr16_b64_v4i16((__attribute__((address_space(3))) v4i16_t*)p)); }
__device__ __forceinline__ float rowmax(const f32x16& p0, const f32x16& p1) {
    float a = max3f(p0[0], p0[1], p1[0]), b = max3f(p0[2], p0[3], p1[1]); a = max3f(a, p1[2], p1[3]);
#pragma unroll
    for (int r = 4; r < 16; r += 4) { a = max3f(a, p0[r], p0[r + 1]); b = max3f(b, p0[r + 2], p0[r + 3]); a = max3f(a, p1[r], p1[r + 1]); b = max3f(b, p1[r + 2], p1[r + 3]); }
    const float m = max2f(a, b);
    auto rr = __builtin_amdgcn_permlane32_swap(__float_as_uint(m), __float_as_uint(m), false, false);
    return max2f(__uint_as_float(rr[0]), __uint_as_float(rr[1]));
}
__device__ __forceinline__ void qkt0(f32x16& p0, f32x16& p1, const char* Kslot, const bf16x8* qr, const f32x16& negm, int r32, int hi) {
    const char* kb = Kslot + hi * 1024 + r32 * 16;
#pragma unroll
    for (int d0 = 0; d0 < 6; ++d0) {
        const bf16x8 b0 = *reinterpret_cast<const bf16x8*>(kb + d0 * 2048);
        const bf16x8 b1 = *reinterpret_cast<const bf16x8*>(kb + d0 * 2048 + 512);
        if (d0 == 0) { p0 = __builtin_amdgcn_mfma_f32_32x32x16_bf16(b0, qr[0], negm, 0, 0, 0); p1 = __builtin_amdgcn_mfma_f32_32x32x16_bf16(b1, qr[0], negm, 0, 0, 0); }
        else { p0 = __builtin_amdgcn_mfma_f32_32x32x16_bf16(b0, qr[d0], p0, 0, 0, 0); p1 = __builtin_amdgcn_mfma_f32_32x32x16_bf16(b1, qr[d0], p1, 0, 0, 0); } }
}
template <int THRL> __device__ __forceinline__ void attn_unit(int b, int h, int qb, const bf16_t* Q, const bf16_t* __restrict__ KN, const bf16_t* __restrict__ KPE, const bf16_t* __restrict__ V, bf16_t* O, char* shm) {
    const int tid = opq(threadIdx.x), lane = tid & 63, r32 = lane & 31, hi = lane >> 5; const int wid = __builtin_amdgcn_readfirstlane(tid >> 6);
    const long rowbase = (long)b * SEQ; const int q0 = qb * 256;
    const bf16_t* Qw = Q + (rowbase + q0 + wid * 32) * QW + h * DQK;
    const unsigned lds0 = (unsigned)(uintptr_t)shm;
    float* wsf = (float*)(shm + P_WS) + wid * 64;
    const bf16_t* ksrc = KN + (rowbase + lane) * 512 + h * 64 + wid * 8;
    const bf16_t* psrc = KPE + (rowbase + lane) * 32 + (wid & 3) * 8;
    const bf16_t* vsrc = V + (rowbase + 16 * (wid & 3) + (lane >> 2)) * 512 + h * 64 + (wid >> 2) * 32 + (lane & 3) * 8;
    const unsigned kdst = lds0 + P_K + wid * 1024, pdst = lds0 + P_K + (8 + (wid & 3)) * 1024, vdst = lds0 + P_V + wid * 1024;
#define DMA_K(t, slot) do { glds16(ksrc + (long)(t) * 64 * 512, (unsigned)__builtin_amdgcn_readfirstlane(kdst + (slot))); if (lowh) glds16(psrc + (long)(t) * 64 * 32, (unsigned)__builtin_amdgcn_readfirstlane(pdst + (slot))); } while (0)
#define DMA_V(t, slot) glds16(vsrc + (long)(t) * 64 * 512, (unsigned)__builtin_amdgcn_readfirstlane(vdst + (slot)))
    const int vb0 = (int)(lds0 + P_V) + ((lane >> 4) & 1) * 32 + (lane & 3) * 8 + (4 * hi + ((lane & 15) >> 2)) * 64;
    const bool lowh = wid < 4;
    const char* Kbase = shm + P_K; bf16x8 kf[8];
    const lds_cptr shm3 = (lds_cptr)shm; const lds_cptr kp0 = shm3 + P_K + hi * 1024 + r32 * 16; const lds_cptr vp0 = shm3 + P_V + ((lane >> 4) & 1) * 32 + (lane & 3) * 8 + (4 * hi + ((lane & 15) >> 2)) * 64;
    const int NT = (q0 + 256) / 64;
    DMA_K(0, 0); DMA_V(0, 0); DMA_K(1, KSLOT);
    bf16x8 qr[6];
#pragma unroll
    for (int d0 = 0; d0 < 6; ++d0) qr[d0] = *reinterpret_cast<const bf16x8*>(&Qw[(long)r32 * QW + d0 * 16 + hi * 8]);
    float mhat = 0.f, l_reg = 0.f; f32x16 o[2], negm;
#pragma unroll
    for (int r = 0; r < 16; ++r) { float z0, z1, z2; asm volatile("v_mov_b32 %0, 0\n\tv_mov_b32 %1, 0\n\tv_mov_b32 %2, 0" : "=v"(z0), "=v"(z1), "=v"(z2)); o[0][r] = z0; o[1][r] = z1; negm[r] = z2; }
    const int qrel = wid * 32 + r32;
#define CMASK(P0, P1, t) do { int jb_ = (t) - (NT - 4); if (jb_ >= 0) cmask(P0, P1, jb_, qrel, hi); } while (0)
    bool resc = false;
#define START(P0, P1) do { const float rm = rowmax(P0, P1); resc = false; \
    { const float dl = rm; mhat = fadd_s(mhat, dl); \
      _Pragma("unroll") for (int r = 0; r < 16; ++r) { P0[r] = fsub_s(P0[r], dl); P1[r] = fsub_s(P1[r], dl); } \
      _Pragma("unroll") for (int r = 0; r < 16; ++r) negm[r] = -mhat; asm volatile("" : "+v"(negm)); } \
    _Pragma("unroll") for (int r = 0; r < 16; ++r) P0[r] = __builtin_amdgcn_exp2f(P0[r]); } while (0)
#define RESC() do { if (resc) { asm volatile("s_waitcnt lgkmcnt(0)" ::: "memory"); \
      _Pragma("unroll") for (int d_ = 0; d_ < 2; ++d_) _Pragma("unroll") for (int r = 0; r < 16; ++r) o[d_][r] *= wsf[crow(r, hi)]; } } while (0)
    f32x16 pA0, pA1, pB0, pB1;
    int ks_m1 = 3 * KSLOT, ks_cur = 0, ks_next = KSLOT;
    int vs_prev = 0, vs_cur = 0, vs_next = VSLOT;
#define ROT() do { ks_m1 = ks_cur; ks_cur = ks_next; ks_next = (ks_next == (NKS - 1) * KSLOT) ? 0 : ks_next + KSLOT; \
                   vs_prev = vs_cur; vs_cur = vs_next; vs_next = (vs_next == (NVS - 1) * VSLOT) ? 0 : vs_next + VSLOT; } while (0)
    DMA_K(2, 2 * KSLOT);
    if (lowh) { WAIT_BAR(5); } else { WAIT_BAR(3); }
    qkt0(pA0, pA1, Kbase, qr, negm, r32, hi); asm volatile("s_nop 15\n\ts_nop 7" : "+v"(pA0), "+v"(pA1)); CMASK(pA0, pA1, 0);
    START(pA0, pA1);
    _Pragma("unroll") for (int r = 0; r < 16; ++r) pA1[r] = __builtin_amdgcn_exp2f(pA1[r]);
    WAIT_BAR(0);
    DMA_K(3, 3 * KSLOT); DMA_V(1, VSLOT);
    ROT();
    kload2(kf, kp0 + ks_cur, 0); kload2(kf, kp0 + ks_cur, 1); kload2(kf, kp0 + ks_cur, 2); kload2(kf, kp0 + ks_cur, 3);
    WB3();
    s16x4 vlo[8], vhi[8]; u32x4 pw0, pw1, pw2, pw3;
#define PKW(P, B) pk2(P[B], P[B + 1])
#define PAF(k) __builtin_bit_cast(bf16x8, pw##k)
#define VFR(i) (bf16x8){vlo[i][0], vlo[i][1], vlo[i][2], vlo[i][3], vhi[i][0], vhi[i][1], vhi[i][2], vhi[i][3]}
#define PIN(x) asm volatile("" : "+v"(x))
#define MX3(a, b, c) __builtin_fmaxf(__builtin_fmaxf((a), (b)), (c))
#define MF_(a, b, c) __builtin_amdgcn_mfma_f32_32x32x16_bf16(a, b, c, 0, 0, 0)
#define GAPA3(MF, A0, A1, A2, W0, W1, PW) do { MF; sacc += A0; sacc += A1; sacc += A2; PIN(sacc); W0; W1; PIN(PW); SBAR(); } while (0)
#define GAPA2(MF, A0, A1, W0, W1, PW) do { MF; sacc += A0; sacc += A1; PIN(sacc); W0; W1; PIN(PW); SBAR(); } while (0)
#define GAPA2N(MF, A0, A1) do { MF; sacc += A0; sacc += A1; PIN(sacc); SBAR(); } while (0)
#define EX(v) __builtin_amdgcn_exp2f(v)
#define GAPB(MF, X, B) do { MF; X[B] = EX(X[B]); X[B + 1] = EX(X[B + 1]); X[B + 2] = EX(X[B + 2]); X[B + 3] = EX(X[B + 3]); PIN(X); SBAR(); } while (0)
#define VRD(i) do { vlo[i] = vtr(vp_ + (((i) >> 2) * 4096 + ((i) & 3) * 1024)); vhi[i] = vtr(vp_ + (((i) >> 2) * 4096 + ((i) & 3) * 1024 + 512)); } while (0)
#define KRD(G, j) do { if (G) { kload2(kf, kp0 + ks_next, j); SBAR(); } } while (0)
#define STEP(C0, C1, P0, P1, t, GK, GV, GL) do { SBAR(); \
    const lds_cptr vp_ = vp0 + vs_prev; const lds_cptr kq_ = kp0 + ks_cur; bf16x8 kl0, kl1, kl2, kl3; \
    float sacc = (P0[0] + P0[1]); \
    kl0 = kld(kq_ + 8192); SBAR();        GAPA3(C0 = MF_(kf[0], qr[0], negm), P0[2], P0[3], P0[4],    pw0[0] = PKW(P0, 0),  pw0[1] = PKW(P0, 2),  pw0); \
    kl1 = kld(kq_ + 8192 + 512); SBAR();  GAPA3(C1 = MF_(kf[1], qr[0], negm), P0[5], P0[6], P0[7],    pw0[2] = PKW(P0, 4),  pw0[3] = PKW(P0, 6),  pw0); \
    kl2 = kld(kq_ + 10240); SBAR();       GAPA3(C0 = MF_(kf[2], qr[1], C0),   P0[8], P0[9], P0[10],   pw1[0] = PKW(P0, 8),  pw1[1] = PKW(P0, 10), pw1); \
    kl3 = kld(kq_ + 10240 + 512); SBAR(); GAPA3(C1 = MF_(kf[3], qr[1], C1),   P0[11], P0[12], P0[13], pw1[2] = PKW(P0, 12), pw1[3] = PKW(P0, 14), pw1); \
    VRD(0); SBAR(); GAPA3(C0 = MF_(kf[4], qr[2], C0), P0[14], P0[15], P1[0], pw2[0] = PKW(P1, 0),  pw2[1] = PKW(P1, 2),  pw2); \
    VRD(4); SBAR(); GAPA3(C1 = MF_(kf[5], qr[2], C1), P1[1], P1[2], P1[3],   pw2[2] = PKW(P1, 4),  pw2[3] = PKW(P1, 6),  pw2); \
    VRD(1); SBAR(); GAPA2(C0 = MF_(kf[6], qr[3], C0), P1[4], P1[5],          pw3[0] = PKW(P1, 8),  pw3[1] = PKW(P1, 10), pw3); \
    VRD(5); SBAR(); GAPA2(C1 = MF_(kf[7], qr[3], C1), P1[6], P1[7],          pw3[2] = PKW(P1, 12), pw3[3] = PKW(P1, 14), pw3); \
    VRD(2); SBAR(); GAPA2N(C0 = MF_(kl0, qr[4], C0), P1[8], P1[9]); \
    VRD(6); SBAR(); GAPA2N(C1 = MF_(kl1, qr[4], C1), P1[10], P1[11]); \
    VRD(3); SBAR(); GAPA2N(C0 = MF_(kl2, qr[5], C0), P1[12], P1[13]); \
    VRD(7); SBAR(); GAPA2N(C1 = MF_(kl3, qr[5], C1), P1[14], P1[15]); \
    l_reg += sacc; \
    if (GK) { DMA_K((t) + 3, ks_m1); } if (GV) { DMA_V((t) + 1, vs_next); } \
    CMASK(C0, C1, t); \
    { float a = MX3(C0[0], C0[1], C1[0]), b = MX3(C0[2], C0[3], C1[1]); a = MX3(a, C1[2], C1[3]); \
      _Pragma("unroll") for (int r = 4; r < 16; r += 4) { a = MX3(a, C0[r], C0[r + 1]); b = MX3(b, C0[r + 2], C0[r + 3]); a = MX3(a, C1[r], C1[r + 1]); b = MX3(b, C1[r + 2], C1[r + 3]); } \
      float rm = __builtin_fmaxf(a, b); { auto rr = __builtin_amdgcn_permlane32_swap(__float_as_uint(rm), __float_as_uint(rm), false, false); rm = __builtin_fmaxf(__uint_as_float(rr[0]), __uint_as_float(rr[1])); } \
      resc = false; \
      if (__builtin_expect(__any(rm > (float)THRL), 0)) { const float dl = __builtin_fmaxf(rm, 0.f); mhat += dl; \
        _Pragma("unroll") for (int r = 0; r < 16; ++r) { C0[r] -= dl; C1[r] -= dl; } \
        _Pragma("unroll") for (int r = 0; r < 16; ++r) negm[r] = -mhat; asm volatile("" : "+v"(negm)); \
        const float f = __builtin_amdgcn_exp2f(-dl); l_reg *= f; if (hi == 0) wsf[r32] = f; resc = true; } } \
    SBAR(); \
    GAPB(o[0] = MF_(PAF(0), VFR(0), o[0]), C0, 0); \
    GAPB(o[1] = MF_(PAF(0), VFR(4), o[1]), C0, 4); \
    KRD(GL, 0); GAPB(o[0] = MF_(PAF(1), VFR(1), o[0]), C0, 8); \
    KRD(GL, 1); GAPB(o[1] = MF_(PAF(1), VFR(5), o[1]), C0, 12); \
    KRD(GL, 2); GAPB(o[0] = MF_(PAF(2), VFR(2), o[0]), C1, 0); \
    KRD(GL, 3); GAPB(o[1] = MF_(PAF(2), VFR(6), o[1]), C1, 4); \
    GAPB(o[0] = MF_(PAF(3), VFR(3), o[0]), C1, 8); \
    GAPB(o[1] = MF_(PAF(3), VFR(7), o[1]), C1, 12); \
    } while (0)
    int t = 1;
#undef CMASK
#define CMASK(P0, P1, t) do { } while (0)
    for (; t + 5 < NT; t += 2) {
        STEP(pB0, pB1, pA0, pA1, t, true, true, true);       WB3(); RESC(); ROT();
        STEP(pA0, pA1, pB0, pB1, t + 1, true, true, true);   WB3(); RESC(); ROT();
    }
#undef CMASK
#define CMASK(P0, P1, t) do { int jb_ = (t) - (NT - 4); if (jb_ >= 0) cmask(P0, P1, jb_, qrel, hi); } while (0)
#define ENDW(tt) do { if ((tt) + 3 < NT) { WB3(); } else if ((tt) + 2 < NT) { WAIT_BAR(1); } else { WAIT_BAR(0); } } while (0)
    for (; t + 1 < NT; t += 2) {
        STEP(pB0, pB1, pA0, pA1, t, (t + 3 < NT), (t + 1 < NT), (t + 1 < NT));       ENDW(t);     RESC(); ROT();
        STEP(pA0, pA1, pB0, pB1, t + 1, (t + 4 < NT), (t + 2 < NT), (t + 2 < NT));   ENDW(t + 1); RESC(); ROT();
    }
    STEP(pB0, pB1, pA0, pA1, NT - 1, false, false, false); RESC();
    { float sacc = pB0[0] + pB0[1]; _Pragma("unroll") for (int r = 2; r < 16; ++r) sacc += pB0[r]; _Pragma("unroll") for (int r = 0; r < 16; ++r) sacc += pB1[r]; l_reg += sacc;
      pw0 = (u32x4){PKW(pB0, 0), PKW(pB0, 2), PKW(pB0, 4), PKW(pB0, 6)}; pw1 = (u32x4){PKW(pB0, 8), PKW(pB0, 10), PKW(pB0, 12), PKW(pB0, 14)};
      pw2 = (u32x4){PKW(pB1, 0), PKW(pB1, 2), PKW(pB1, 4), PKW(pB1, 6)}; pw3 = (u32x4){PKW(pB1, 8), PKW(pB1, 10), PKW(pB1, 12), PKW(pB1, 14)};
      SBAR(); pv(o, vb0 + vs_cur, PAF(0), PAF(1), PAF(2), PAF(3)); }
#undef PKW
#undef PAF
#undef VFR
#undef PIN
#undef MX3
#undef MF_
#undef GAPA3
#undef GAPA2
#undef GAPA2N
#undef GAPB
#undef EX
#undef VRD
#undef KRD
#undef STEP
#undef ENDW
    { auto rr = __builtin_amdgcn_permlane32_swap(__float_as_uint(l_reg), __float_as_uint(l_reg), false, false); l_reg = __uint_as_float(rr[0]) + __uint_as_float(rr[1]); }
    if (hi == 0) wsf[32 + r32] = l_reg; asm volatile("s_waitcnt lgkmcnt(0)" ::: "memory");
    float rli[16];
#pragma unroll
    for (int r = 0; r < 16; ++r) rli[r] = __builtin_amdgcn_rcpf(wsf[32 + crow(r, hi)]);
    bf16_t* Ow = O + (rowbase + q0 + wid * 32) * 1024 + h * 64;
    { bf16_t* stg = (bf16_t*)(shm + P_OST) + wid * 2048;
#pragma unroll
        for (int r = 0; r < 16; ++r) { const int orow = crow(r, hi);
#pragma unroll
            for (int d0 = 0; d0 < 2; ++d0) stg[orow * 64 + d0 * 32 + r32] = f2bf(o[d0][r] * rli[r]); }
        asm volatile("s_waitcnt lgkmcnt(0)" ::: "memory");
#pragma unroll
        for (int i = 0; i < 4; ++i) { const int row = i * 8 + (lane >> 3), ch = lane & 7; const u32x4 v = *(const u32x4*)(stg + row * 64 + ch * 8); *(u32x4*)(Ow + (long)row * 1024 + ch * 8) = v; } }
    asm volatile("s_waitcnt lgkmcnt(0)\n\ts_barrier" ::: "memory");
#undef DMA_K
#undef DMA_V
#undef CMASK
#undef START
#undef RESC
#undef ROT
#undef WAIT_BAR
#undef WB3
}
#undef SBAR
}

typedef GAS unsigned gu32;
#define RLX_AGENT __ATOMIC_RELAXED, __HIP_MEMORY_SCOPE_AGENT
#define XB_TMO      128
#define XB_XCNT(j)  (256  + 64 * (j))
#define XB_XSUB(j)  (1280 + 64 * (j))
#define XB_XGEN(j)  (2304 + 64 * (j))
#define XB_TOP      3328
#define XB_TOPGEN   3392
#define XCD_BAR_WORDS 3456
#define XB_SPIN_CAP (1u << 22)
__device__ __forceinline__ unsigned xb_ld(unsigned* p)              { return __hip_atomic_load(p, __ATOMIC_RELAXED, __HIP_MEMORY_SCOPE_AGENT); }
__device__ __forceinline__ unsigned xb_add(unsigned* p, unsigned v) { return __hip_atomic_fetch_add(p, v, __ATOMIC_RELAXED, __HIP_MEMORY_SCOPE_AGENT); }
__device__ __forceinline__ unsigned xb_xcc_id() { return (unsigned)__builtin_amdgcn_s_getreg((3 << 11) | 20) & 0xFu; }
#define XB_SPIN(cond, bar) do { unsigned _sp = 0; while (cond) { __builtin_amdgcn_s_sleep(1); \
    if ((++_sp & 255u) == 0u) { if (xb_ld(&(bar)[XB_TMO])) break; if (_sp > XB_SPIN_CAP) { atomicAdd(&(bar)[XB_TMO], 1u); break; } } } } while (0)
struct XcdBarrier { unsigned* bar; unsigned x; volatile LAS unsigned* st; };
__device__ __forceinline__ XcdBarrier xcd_barrier_post(unsigned* bar, volatile LAS unsigned* st) {
    XcdBarrier b; b.bar = bar; b.x = xb_xcc_id(); b.st = st;
    if (threadIdx.x == 0) (void)xb_add(&bar[XB_XCNT(b.x)], 1u);
    return b;
}
__device__ __forceinline__ void xcd_barrier_complete(unsigned* bar, unsigned x, unsigned& nloc, unsigned& nx) {
    const unsigned G = gridDim.x * gridDim.y * gridDim.z;
    unsigned sum, cnt, mine, sp = 0u;
    for (;;) {
        sum = 0u; cnt = 0u; mine = 0u;
#pragma unroll
        for (unsigned j = 0; j < 16; ++j) { const unsigned c = xb_ld(&bar[XB_XCNT(j)]); sum += c; cnt += (c > 0u) ? 1u : 0u; mine = (j == x) ? c : mine; }
        if (sum == G) break;
        __builtin_amdgcn_s_sleep(1);
        if ((++sp & 255u) == 0u) { if (xb_ld(&bar[XB_TMO])) break; if (sp > XB_SPIN_CAP) { atomicAdd(&bar[XB_TMO], 1u); break; } }
    }
    nloc = mine > 0u ? mine : 1u; nx = cnt > 0u ? cnt : 1u;
}
__device__ __forceinline__ void xcd_barrier(const XcdBarrier& b) {
    asm volatile("s_waitcnt vmcnt(0)" ::: "memory");
    __syncthreads();
    if (threadIdx.x == 0) {
        unsigned* bar = b.bar;
        __builtin_amdgcn_s_waitcnt(0);
        unsigned nloc = b.st[0], nx = b.st[1];
        if (nloc == 0u) { xcd_barrier_complete(bar, b.x, nloc, nx); b.st[0] = nloc; b.st[1] = nx; }
        const unsigned old = xb_add(&bar[XB_XSUB(b.x)], 1u);
        const unsigned gen = old / nloc;
        if (old + 1u == (gen + 1u) * nloc) {
            __builtin_amdgcn_fence(__ATOMIC_RELEASE, "agent");
            asm volatile("s_waitcnt vmcnt(0)" ::: "memory");
            const unsigned og = xb_add(&bar[XB_TOP], 1u);
            const unsigned tg = og / nx;
            if (og + 1u == (tg + 1u) * nx) xb_add(&bar[XB_TOPGEN], 1u);
            else XB_SPIN(xb_ld(&bar[XB_TOPGEN]) == tg, bar);
            __builtin_amdgcn_fence(__ATOMIC_ACQUIRE, "agent");
            xb_add(&bar[XB_XGEN(b.x)], 1u);
            asm volatile("s_waitcnt vmcnt(0)" ::: "memory");
        } else {
            XB_SPIN(xb_ld(&bar[XB_XGEN(b.x)]) == gen, bar);
            __builtin_amdgcn_fence(__ATOMIC_ACQUIRE, "agent");
            asm volatile("s_waitcnt vmcnt(0)" ::: "memory");
        }
    }
    __syncthreads();
}

struct Args { const void* in[27]; float* out; unsigned char* ws; int ph_lo, ph_hi, dup, bar_rep; };
enum { I_X = 0, I_C, I_POS, I_WADA, I_BADA, I_N1G, I_WIN, I_QNG, I_WUQ, I_KVNG, I_WUKV, I_VNG, I_VNB, I_WS, I_BS, I_WBRM, I_WBRS, I_WOUT, I_N2G, I_WRG, I_BRG, I_WRE, I_BRE, I_W1, I_W3, I_W2, I_FG };
constexpr int NPHASE = 12;

__device__ __forceinline__ int ropeidx(int p) { return 4 * (p >> 3) + (p & 3) + 16 * ((p >> 2) & 1); }

__device__ __forceinline__ void tr_item(const float* W, int N, int k0, int n0, bf16_t* WT, int ldk, int drow0, const float* gk, float mul, bool rp, LAS float* scr, int lane, int dcol0 = 0) {
#pragma unroll 8
    for (int i = 0; i < 32; ++i) { const int kk = 2 * i + (lane >> 5); float v = W[(size_t)(k0 + kk) * N + n0 + (lane & 31)]; if (gk) v *= gk[k0 + kk]; scr[kk * 33 + (lane & 31)] = v * mul; }
    LDS_WAIT(); asm volatile("" ::: "memory");
    const int c = lane & 7;
#pragma unroll
    for (int j = 0; j < 4; ++j) { const int p = (lane >> 3) + 8 * j; const int n = rp ? ropeidx(p) : p; const LAS float* s = scr + (8 * c) * 33 + n;
        u32x4 o; o.x = pk2(s[0 * 33], s[1 * 33]); o.y = pk2(s[2 * 33], s[3 * 33]); o.z = pk2(s[4 * 33], s[5 * 33]); o.w = pk2(s[6 * 33], s[7 * 33]);
        *(u32x4*)(WT + (size_t)(drow0 + p) * ldk + dcol0 + k0 + 8 * c) = o; }
    LDS_WAIT(); asm volatile("" ::: "memory");
}
__device__ __forceinline__ int win_drow(int n) {
    if (n < 416) return n; if (n < 1440) return n + 96;
    if (n < 2464) { const int c = n - 1440; return 1536 + 256 * (c >> 7) + (c & 127); }
    const int c = n - 2464; return 1536 + 256 * (c >> 7) + 128 + (c & 127);
}

__device__ __forceinline__ void wg_tile(const float* W, int N, int k0, int n0, bf16_t* WT, int ldk, int dbase, int dcol0, bool il, LAS float* tile, int wave, int lane) {
    f32x4 v[8];
#pragma unroll
    for (int i = 0; i < 8; ++i) v[i] = __builtin_nontemporal_load((const f32x4*)(W + (size_t)(k0 + 8 * wave + i) * N + n0 + 4 * lane));
#pragma unroll
    for (int i = 0; i < 8; ++i) { LAS float* tp_ = tile + (8 * wave + i) * 257 + 4 * lane; tp_[0] = v[i][0]; tp_[1] = v[i][1]; tp_[2] = v[i][2]; tp_[3] = v[i][3]; }
    __syncthreads();
    const int c = lane & 7;
#pragma unroll
    for (int j = 0; j < 4; ++j) { const int nl = 32 * wave + (lane >> 3) + 8 * j, n = n0 + nl; const LAS float* sp_ = tile + (8 * c) * 257 + nl;
        u32x4 o; o.x = pk2(sp_[0 * 257], sp_[1 * 257]); o.y = pk2(sp_[2 * 257], sp_[3 * 257]); o.z = pk2(sp_[4 * 257], sp_[5 * 257]); o.w = pk2(sp_[6 * 257], sp_[7 * 257]);
        const int drow = il ? dbase + 256 * (n >> 7) + (n & 127) : dbase + n;
        *(u32x4*)(WT + (size_t)drow * ldk + dcol0 + k0 + 8 * c) = o; }
    __syncthreads();
}

typedef const char __attribute__((address_space(4)))* kargp_t;
__device__ __forceinline__ kargp_t launder_k(kargp_t p) { asm volatile("" : "+s"(p)); return p; }
#define KIN(k) (*(const void* const __attribute__((address_space(4)))*)(launder_k(kbase) + 8 * (k)))
__global__ void __launch_bounds__(NWAVES * 64, 2) fwd_kernel(Args args) {
    const kargp_t kbase = (kargp_t)__builtin_amdgcn_kernarg_segment_ptr();
    extern __shared__ __attribute__((aligned(16))) unsigned char lds[];
    LAS unsigned char* const L = (LAS unsigned char*)lds;
    volatile LAS unsigned* const MISC = (volatile LAS unsigned*)(L + MISC_OFF);
    const int tid0 = threadIdx.x, wave = __builtin_amdgcn_readfirstlane(tid0 >> 6);
    const int G = gridDim.x; const int bx = blockIdx.x; const int vcu = (G % 8 == 0) ? (bx % 8) * (G / 8) + bx / 8 : bx;
    const int gw = vcu * NWAVES + wave, NGW = G * NWAVES;
    unsigned char* const ws = args.ws;
    unsigned* const ctl = (unsigned*)(ws + WS_CTL);
    float* const mod = (float*)(ws + WS_MOD);
    float* const ssqq = (float*)(ws + WS_SSQQ); float* const ssqkv = (float*)(ws + WS_SSQKV);
    unsigned* const ecnt = ctl + CW_CNT;
    const float* const x = (const float*)KIN(I_X);
    float* const out = args.out;
    for (int u = tid0; u < 64; u += NWAVES * 64) MISC[u] = 0u;
    __syncthreads();
    const int lo = args.ph_lo, hi = args.ph_hi, dupm = args.dup, barrep = args.bar_rep;
    XcdBarrier bar; bar.bar = ctl + CW_BAR; bar.x = 0; bar.st = nullptr;
    if (hi - lo > 1) bar = xcd_barrier_post(ctl + CW_BAR, MISC + 8);
#ifndef PH_MASK
#define PH_MASK 0xFFF
#endif
#ifndef DUP_MASK
#define DUP_MASK 0
#endif
#define REP(k) for (int rep_ = 0; rep_ < 1 + ((dupm >> (k)) & 1); ++rep_)
#define IN(k) (((PH_MASK >> (k)) & 1) && lo <= (k) && (k) < hi)
#ifndef BAR_REP
#define BAR_REP 1
#endif
#define SEAM(k) do { if (IN(k) && IN((k) + 1)) for (int b_ = 0; b_ < barrep; ++b_) xcd_barrier(bar); } while (0)

    if (IN(0)) REP(0) {
        const int tid = opq(tid0), lane = tid & 63; (void)tid;
        LAS float* scr = (LAS float*)(L + wave * 16384);
        bf16_t* const WIN = (bf16_t*)(ws + WS_WIN); bf16_t* const WUP = (bf16_t*)(ws + WS_WUP); bf16_t* const WBR = (bf16_t*)(ws + WS_WBR);
        bf16_t* const WOUT = (bf16_t*)(ws + WS_WOUT); bf16_t* const W13 = (bf16_t*)(ws + WS_W13); bf16_t* const W2 = (bf16_t*)(ws + WS_W2);
        { constexpr int T13 = NEXP * 16 * 2, TOUT = 16 * 4, TBR = 8 * 4, NTILE = 2 * T13 + TOUT + 2 * TBR - W13_LATE;
            LAS float* tile = (LAS float*)L;
            for (int it = G - 1 - vcu; it < NTILE; it += G) {
                int r = it + W13_LATE;
                if (r < 2 * T13) { const int kind = r / T13; r %= T13; const int e = r / 32, q = r % 32;
                    wg_tile((const float*)KIN(kind ? I_W3 : I_W1) + (size_t)e * DM * EFF, EFF, 64 * (q >> 1), 256 * (q & 1), W13, DM, e * 1024 + 128 * kind, 0, true, tile, wave, lane); }
                else if ((r -= 2 * T13) < TOUT) wg_tile((const float*)KIN(I_WOUT), DM, 64 * (r >> 2), 256 * (r & 3), WOUT, DM, 0, 0, false, tile, wave, lane);
                else { r -= TOUT; const int br = r / TBR; r %= TBR; wg_tile((const float*)KIN(br ? I_WBRS : I_WBRM), DM, 64 * (r >> 2), 256 * (r & 3), WBR, DM, 0, br * 512, false, tile, wave, lane); }
            }
        }
        constexpr int I_IN = 16 * 109, I_UQ = 4 * 24, I_UKV = 2 * 32;
        constexpr int NIT = I_IN + I_UQ + I_UKV;
        for (int it = gw; it < NIT; it += NGW) {
            int r = it;
            if (r < I_IN) { const int kb = r / 109, nb = r % 109; tr_item((const float*)KIN(I_WIN), INW, 64 * kb, 32 * nb, WIN, DM, win_drow(32 * nb), nullptr, 1.f, false, scr, lane); continue; } r -= I_IN;
            if (r < I_UQ) { const int kb = r / 24, nb = r % 24; tr_item((const float*)KIN(I_WUQ), QW, 64 * kb, 32 * nb, WUP, 256, 32 * nb, (const float*)KIN(I_QNG), C2, (nb % 3) == 2, scr, lane); continue; } r -= I_UQ;
            { const int kb = r / 32, nb = r % 32; tr_item((const float*)KIN(I_WUKV), 1024, 64 * kb, 32 * nb, WUP, 256, 768 + 32 * nb, (const float*)KIN(I_KVNG), 1.f, false, scr, lane); }
        }
        for (int it = gw; it < 96 * 2 + 1024 / 4; it += NGW) {
            const u32x4 z = {0u, 0u, 0u, 0u};
            if (it < 192) { const int row = 416 + it / 2, c0 = (it & 1) * 512 + lane * 8; *(u32x4*)(WIN + (size_t)row * DM + c0) = z; }
            else { const int row = 768 + (it - 192) * 4 + (lane >> 4), c0 = 128 + (lane & 15) * 8; *(u32x4*)(WUP + (size_t)row * 256 + c0) = z; }
        }
        { const float* wada = (const float*)KIN(I_WADA); const float* badA = (const float*)KIN(I_BADA); const float* cvec = (const float*)KIN(I_C);
            LAS float* part = (LAS float*)(L + 12288);
            for (int cg = vcu; cg < 96; cg += G) { const int col = 64 * cg + lane; float s0 = 0.f, s1 = 0.f;
#pragma unroll
                for (int kk = 0; kk < 2; ++kk) { const int kb = 128 * wave + 64 * kk;
                    const float c0 = cvec[kb + lane], c1 = cvec[DM + kb + lane]; const float a0 = c0 * sigmoidf_(c0), a1 = c1 * sigmoidf_(c1);
#pragma unroll 16
                    for (int k = 0; k < 64; ++k) { const float w = wada[(size_t)(kb + k) * 6144 + col]; s0 += __shfl(a0, k) * w; s1 += __shfl(a1, k) * w; } }
                part[(wave * 2 + 0) * 64 + lane] = s0; part[(wave * 2 + 1) * 64 + lane] = s1;
                __syncthreads();
                if (tid < 128) { const int b = tid >> 6, l = tid & 63; float a = badA[64 * cg + l];
#pragma unroll
                    for (int w = 0; w < 8; ++w) a += part[(w * 2 + b) * 64 + l];
                    mod[b * 6144 + 64 * cg + l] = a; }
                __syncthreads(); } }
        { const int* pos = (const int*)KIN(I_POS); f32x2* cs = (f32x2*)(ws + WS_CS);
            for (int it = gw * 64 + lane; it < NTOK * 16; it += NGW * 64) { const int tok = it >> 4, i = it & 15;
                const float freq = powf(10000.0f, -(float)i / 16.0f); const float ang = (float)pos[tok] * freq;
                const double rv = (double)ang * 0.15915494309189535; const float fr = (float)(rv - rint(rv));
                cs[it] = (f32x2){__builtin_amdgcn_cosf(fr), __builtin_amdgcn_sinf(fr)}; } }
        { const float* wsp = (const float*)KIN(I_WS); bf16_t* wst = (bf16_t*)(ws + WS_WSTRIL);
            for (int it = gw * 64 + lane; it < 8 * 128 * 128; it += NGW * 64) { const int t = (it >> 7) & 127, s = it & 127; wst[it] = f2bf(s <= t ? wsp[it] : 0.f); } }
    }
    SEAM(0);

    if (IN(1)) REP(1) {
        const int tid = opq(tid0), lane = tid & 63; (void)tid;
        bf16_t* XN = (bf16_t*)(ws + WS_XN); const float* g1 = (const float*)KIN(I_N1G);
        for (int mi = 0; mi < NTOK / NGW; ++mi) { const int m = (gw / NWAVES) * (NTOK / G) + mi * NWAVES + (gw % NWAVES); const float* md = mod + (m / SEQ) * 6144;
            const f32x4* xr = (const f32x4*)(x + (size_t)m * DM) + lane; f32x4 v[4]; float s = 0.f;
#pragma unroll
            for (int j = 0; j < 4; ++j) { v[j] = __builtin_nontemporal_load(xr + 64 * j); s += (v[j][0] * v[j][0] + v[j][1] * v[j][1]) + (v[j][2] * v[j][2] + v[j][3] * v[j][3]); }
            const float rs = 1.0f / sqrtf(wave_sum(s) * (1.f / DM) + EPS);
            u32x2* o8 = (u32x2*)(XN + (size_t)m * DM) + lane;
#pragma unroll
            for (int j = 0; j < 4; ++j) { const int col = 256 * j + 4 * lane; const f32x4 gg = *(const f32x4*)(g1 + col), sc = *(const f32x4*)(md + 1024 + col), sh = *(const f32x4*)(md + col);
                const f32x4 h = v[j] * rs * gg * (sc + 1.0f) + sh; o8[64 * j] = (u32x2){pk2(h[0], h[1]), pk2(h[2], h[3])}; } }
        { const float* g2 = (const float*)KIN(I_N2G); const float* wrg = (const float*)KIN(I_WRG); const float* wre = (const float*)KIN(I_WRE);
            const float* brg = (const float*)KIN(I_BRG); const float* bre = (const float*)KIN(I_BRE); float* BP = (float*)(ws + WS_BIASP);
            bf16_t* WPH = (bf16_t*)(ws + WS_WPH); bf16_t* WPL = (bf16_t*)(ws + WS_WPL);
            for (int it = gw * 64 + lane; it < 2 * 64 * 1024; it += NGW * 64) { const int b = it >> 16, n = (it >> 10) & 63, k = it & 1023;
                float w = 0.f; if (n < 36) w = g2[k] * (1.0f + mod[b * 6144 + 4096 + k]) * ((n < 4) ? wrg[k * 4 + n] : wre[k * 32 + n - 4]);
                const bf16_t h = f2bf(w); WPH[it] = h; WPL[it] = f2bf(w - bf2f(h)); }
            for (int it = gw; it < 72; it += NGW) { const int b = it / 36, n = it % 36; float a = 0.f;
                for (int k = lane; k < 1024; k += 64) a += mod[b * 6144 + 3072 + k] * ((n < 4) ? wrg[k * 4 + n] : wre[k * 32 + n - 4]);
                a = wave_sum(a); if (lane == 0) BP[it] = a + ((n < 4) ? brg[n] : bre[n - 4]); } }
    }
    SEAM(1);

    if (IN(2)) REP(2) {
        pg8::Gemm g{(const bf16_t*)(ws + WS_XN), (const bf16_t*)(ws + WS_WIN), DM, DM};
        OrderGrid S; S.gm.init(NTOK / 256, NPROJ / 256); S.G = G; S.c = bx; S.split_pn = 1000; S.acol_hi = 0;
        EpiProj E{(bf16_t*)(ws + WS_CQKV), (bf16_t*)(ws + WS_AS) + 512, (bf16_t*)(ws + WS_SGUV), (bf16_t*)(ws + WS_GATES), ssqq, ssqkv};
        pg8::gemm_phase<EpiProj, OrderGrid, false>(L, g, S, E, nullptr);
    }
    SEAM(2);

    if (IN(3)) REP(3) {
        const int tid = opq(tid0), lane = tid & 63; (void)tid;
        pg8::Gemm g{(const bf16_t*)(ws + WS_CQKV), (const bf16_t*)(ws + WS_WUP), 512, 256};
        OrderGrid S; S.gm.init(NTOK / 256, 7); S.G = G; S.c = bx; S.split_pn = 3; S.acol_hi = 256;
        EpiUp E{(bf16_t*)(ws + WS_Q), (bf16_t*)(ws + WS_KN), (bf16_t*)(ws + WS_V), ssqq, ssqkv, (const f32x4*)(ws + WS_CS)};
        pg8::gemm_phase<EpiUp, OrderGrid, false>(L, g, S, E, nullptr);
        { const bf16_t* cq = (const bf16_t*)(ws + WS_CQKV); bf16_t* kpe = (bf16_t*)(ws + WS_KPE); const f32x2* cs = (const f32x2*)(ws + WS_CS);
            for (int it = gw * 64 + lane; it < NTOK * 32; it += NGW * 64) { const int tok = it >> 5, p = it & 31, i = 4 * (p >> 3) + (p & 3), n = (p >> 2) & 1;
                const float x1 = bf2f(cq[(size_t)tok * 512 + 384 + i]), x2 = bf2f(cq[(size_t)tok * 512 + 384 + 16 + i]); const f32x2 c = cs[tok * 16 + i];
                kpe[it] = f2bf(n ? x1 * c[1] + x2 * c[0] : x1 * c[0] - x2 * c[1]); } }
    }
    if (IN(3)) REP(5) {
        const int tid = opq(tid0), lane = tid & 63; (void)tid;
        const bf16_t* SV = (const bf16_t*)(ws + WS_SGUV); bf16_t* SO = (bf16_t*)(ws + WS_AS) + 512;
        const bf16_t* wst = (const bf16_t*)(ws + WS_WSTRIL); const float* vng = (const float*)KIN(I_VNG); const float* vnb = (const float*)KIN(I_VNB); const float* bs = (const float*)KIN(I_BS);
        for (int ch = vcu; ch < NTOK / 128; ch += G) {
            const int tok0 = ch * 128;
            float gn[8], bn[8];
#pragma unroll
            for (int i = 0; i < 8; ++i) { gn[i] = vng[lane + 64 * i]; bn[i] = vnb[lane + 64 * i]; }
            for (int rr = 0; rr < 16; ++rr) { const int sp = wave * 16 + rr; const bf16_t* vr = SV + (size_t)(tok0 + sp) * 512; float xv[8]; float s = 0.f, s2 = 0.f;
#pragma unroll
                for (int i = 0; i < 8; ++i) { xv[i] = bf2f(vr[lane + 64 * i]); s += xv[i]; }
                const float mu = wave_sum(s) * (1.f / 512.f);
#pragma unroll
                for (int i = 0; i < 8; ++i) { xv[i] -= mu; s2 += xv[i] * xv[i]; }
                const float rstd = 1.0f / sqrtf(wave_sum(s2) * (1.f / 512.f) + EPS);
#pragma unroll
                for (int i = 0; i < 8; ++i) { const int c = lane + 64 * i; *(LAS bf16_t*)(L + c * 256 + ((((sp >> 3) ^ (c & 15)) << 4) | ((sp & 7) << 1))) = f2bf(xv[i] * rstd * gn[i] + bn[i]); } }
            __syncthreads();
            { const int g = wave, r32 = lane & 31, hh = lane >> 5;
#pragma unroll 1
                for (int tb = 0; tb < 4; ++tb) { f32x16 acc[2]; acc[0] = f32x16{}; acc[1] = f32x16{};
#pragma unroll 2
                    for (int ks = 0; ks < 2 * tb + 2; ++ks) {
                        const bf16x8 a = *(const bf16x8*)(wst + (size_t)g * 16384 + (32 * tb + r32) * 128 + 16 * ks + 8 * hh);
#pragma unroll
                        for (int cb = 0; cb < 2; ++cb) { const int c = 64 * g + 32 * cb + r32;
                            const bf16x8 b = *(const LAS bf16x8*)(L + c * 256 + (((2 * ks + hh) ^ (c & 15)) << 4));
                            acc[cb] = __builtin_amdgcn_mfma_f32_32x32x16_bf16(a, b, acc[cb], 0, 0, 0); } }
#pragma unroll
                    for (int r = 0; r < 16; ++r) { const int t = 32 * tb + (r & 3) + 8 * (r >> 2) + 4 * hh; const float bb = bs[g * 128 + t];
#pragma unroll
                        for (int cb = 0; cb < 2; ++cb) { const size_t off = (size_t)(tok0 + t) * 1024 + 64 * g + 32 * cb + r32; SO[off] = f2bf((acc[cb][r] + bb) * bf2f(SO[off])); } } }
            }
            __syncthreads();
        }
        if (bx >= G / 2) for (int it = bx - G / 2; it < W13_LATE; it += G - G / 2) { const int e = it / 32, q = it % 32;
            wg_tile((const float*)KIN(I_W1) + (size_t)e * DM * EFF, EFF, 64 * (q >> 1), 256 * (q & 1), (bf16_t*)(ws + WS_W13), DM, e * 1024, 0, true, (LAS float*)L, wave, lane); }
    }
    SEAM(3);

    if (IN(4)) REP(4) {
        const int bh = vcu >> 4, s = vcu & 15;
        for (int i = 0; i < 4; ++i) { const int qb = (i == 0) ? s : (i == 1) ? 31 - s : (i == 2) ? 32 + s : 63 - s;
            attn::attn_unit<8>(bh >> 3, bh & 7, qb, (const bf16_t*)(ws + WS_Q), (const bf16_t*)(ws + WS_KN), (const bf16_t*)(ws + WS_KPE), (const bf16_t*)(ws + WS_V), (bf16_t*)(ws + WS_AS), (char*)lds); }
    }
    SEAM(4);


    if (IN(6)) REP(6) {
        pg8::Gemm g{(const bf16_t*)(ws + WS_AS), (const bf16_t*)(ws + WS_WBR), DM, DM};
        OrderGrid S; S.gm.init(NTOK / 256, 4); S.G = G; S.c = bx; S.split_pn = 1000; S.acol_hi = 0;
        EpiBranch E{(const bf16_t*)(ws + WS_GATES), (bf16_t*)(ws + WS_MERGED)};
        pg8::gemm_phase<EpiBranch, OrderGrid, false>(L, g, S, E, nullptr);
    }
    SEAM(6);

    if (IN(7)) REP(7) {
        pg8::Gemm g{(const bf16_t*)(ws + WS_MERGED), (const bf16_t*)(ws + WS_WOUT), DM, DM};
        OrderGrid S; S.gm.init(NTOK / 256, 4); S.G = G; S.c = bx; S.split_pn = 1000; S.acol_hi = 0;
        EpiOut E{x, mod, (bf16_t*)(ws + WS_X1B)};
        pg8::gemm_phase<EpiOut, OrderGrid, false>(L, g, S, E, nullptr);
    }
    SEAM(7);

    if (IN(8)) REP(8) {
        const int tid = opq(tid0), lane = tid & 63; (void)tid;
        bf16_t* H2 = (bf16_t*)(ws + WS_H2); const float* g2 = (const float*)KIN(I_N2G);
        const float* BP = (const float*)(ws + WS_BIASP);
        unsigned* list = (unsigned*)(ws + (rep_ ? WS_Y : WS_LIST)); float* lw = (float*)(ws + (rep_ ? WS_Y + 16 * MiB : WS_LW)); unsigned* const ecnt_ = ecnt + (rep_ ? 32 : 0);
        LAS float* part = (LAS float*)L;
        LAS float* rsl = (LAS float*)(L + 114688);
        const bf16_t* WPH = (const bf16_t*)(ws + WS_WPH); const bf16_t* WPL = (const bf16_t*)(ws + WS_WPL); const bf16_t* X1B = (const bf16_t*)(ws + WS_X1B);
        const int r32 = lane & 31, hh = lane >> 5;
        for (int blk = vcu; blk < NTOK / 128; blk += G) {
            const int row0 = blk * 128, b = row0 / SEQ; const int rh = wave & 1, ksl = wave >> 1;
            f32x16 acc[2][2]; float sq[2] = {0.f, 0.f};
#pragma unroll
            for (int i = 0; i < 2; ++i)
#pragma unroll
                for (int j = 0; j < 2; ++j) acc[i][j] = f32x16{};
#pragma unroll 4
            for (int ks = 0; ks < 16; ++ks) { const int k = 256 * ksl + 16 * ks + 8 * hh;
                bf16x8 bh[2], bl[2];
#pragma unroll
                for (int cb = 0; cb < 2; ++cb) { bh[cb] = *(const bf16x8*)(WPH + (size_t)(b * 64 + 32 * cb + r32) * 1024 + k); bl[cb] = *(const bf16x8*)(WPL + (size_t)(b * 64 + 32 * cb + r32) * 1024 + k); }
#pragma unroll
                for (int rb = 0; rb < 2; ++rb) { const u32x4 xw = *(const u32x4*)(X1B + (size_t)(row0 + 64 * rh + 32 * rb + r32) * DM + k);
                    const float e0 = bflo(xw.x), e1 = bfhi(xw.x), e2 = bflo(xw.y), e3 = bfhi(xw.y), e4 = bflo(xw.z), e5 = bfhi(xw.z), e6 = bflo(xw.w), e7 = bfhi(xw.w);
                    sq[rb] += (e0 * e0 + e1 * e1) + (e2 * e2 + e3 * e3) + (e4 * e4 + e5 * e5) + (e6 * e6 + e7 * e7);
                    const bf16x8 ah = __builtin_bit_cast(bf16x8, xw);
#pragma unroll
                    for (int cb = 0; cb < 2; ++cb) { acc[rb][cb] = __builtin_amdgcn_mfma_f32_32x32x16_bf16(ah, bh[cb], acc[rb][cb], 0, 0, 0); acc[rb][cb] = __builtin_amdgcn_mfma_f32_32x32x16_bf16(ah, bl[cb], acc[rb][cb], 0, 0, 0); } } }
#pragma unroll
            for (int rb = 0; rb < 2; ++rb) { const int rbase = ksl * 128 + 64 * rh + 32 * rb;
#pragma unroll
                for (int cb = 0; cb < 2; ++cb) { const int c = 32 * cb + r32;
                    if (c < 36) {
#pragma unroll
                        for (int r = 0; r < 16; ++r) part[(rbase + (r & 3) + 8 * (r >> 2) + 4 * hh) * 37 + c] = acc[rb][cb][r]; } }
                const float sv = sq[rb] + __shfl_xor(sq[rb], 32); if (hh == 0) part[(rbase + r32) * 37 + 36] = sv; }
            __syncthreads();
            if (wave < 2) {
                const int row = 64 * wave + lane;
                float tot[5];
#pragma unroll
                for (int n = 0; n < 5; ++n) { const int nn = (n < 4) ? n : 36; float a = part[row * 37 + nn];
#pragma unroll
                    for (int w = 1; w < 4; ++w) a += part[(w * 128 + row) * 37 + nn];
                    tot[n] = a; }
                const float rs = 1.0f / sqrtf(tot[4] * (1.f / DM) + EPS); rsl[row] = rs;
                float gl[4];
#pragma unroll
                for (int q = 0; q < 4; ++q) gl[q] = rs * tot[q] + BP[b * 36 + q];
                int grp = 0; float gmax = gl[0];
#pragma unroll
                for (int q = 1; q < 4; ++q) if (gl[q] > gmax) { gmax = gl[q]; grp = q; }
                float gs = 0.f;
#pragma unroll
                for (int q = 0; q < 4; ++q) gs += expf(gl[q] - gmax);
                const float pgrp = 1.0f / gs;
                float el[8];
#pragma unroll
                for (int q = 0; q < 8; ++q) { const int nn = 4 + 8 * grp + q; float t = part[row * 37 + nn];
#pragma unroll
                    for (int w = 1; w < 4; ++w) t += part[(w * 128 + row) * 37 + nn];
                    el[q] = rs * t + BP[b * 36 + nn]; }
                int i0 = 0; float m0 = el[0];
#pragma unroll
                for (int q = 1; q < 8; ++q) if (el[q] > m0) { m0 = el[q]; i0 = q; }
                int i1 = -1; float m1 = -INFINITY;
#pragma unroll
                for (int q = 0; q < 8; ++q) if (q != i0 && el[q] > m1) { m1 = el[q]; i1 = q; }
                const float d = expf(m1 - m0), t0 = 1.0f / (1.0f + d), t1 = d * t0;
                const int e0 = 8 * grp + i0, e1 = 8 * grp + i1; const unsigned m = (unsigned)(row0 + row);
                LAS unsigned* hist = (LAS unsigned*)(L + 115200 + wave * 256);
                if (lane < 32) hist[lane] = 0u;
                asm volatile("s_waitcnt lgkmcnt(0)" ::: "memory");
                const unsigned r0 = __hip_atomic_fetch_add(hist + e0, 1u, __ATOMIC_RELAXED, __HIP_MEMORY_SCOPE_WORKGROUP);
                const unsigned r1 = __hip_atomic_fetch_add(hist + e1, 1u, __ATOMIC_RELAXED, __HIP_MEMORY_SCOPE_WORKGROUP);
                asm volatile("s_waitcnt lgkmcnt(0)" ::: "memory");
                if (lane < 32) { const unsigned c = hist[lane]; unsigned base = 0u; if (c) base = atomicAdd(ecnt_ + lane * 64, c); hist[32 + lane] = base; }
                asm volatile("s_waitcnt vmcnt(0) lgkmcnt(0)" ::: "memory");
                const unsigned p0 = hist[32 + e0] + r0, p1 = hist[32 + e1] + r1;
                list[(size_t)e0 * ECAP + p0] = 2u * m; lw[(size_t)e0 * ECAP + p0] = pgrp * t0;
                list[(size_t)e1 * ECAP + p1] = 2u * m + 1u; lw[(size_t)e1 * ECAP + p1] = pgrp * t1;
            }
            __syncthreads();
            const float* md = mod + b * 6144;
#pragma unroll 4
            for (int i = 0; i < 16; ++i) { const int m = row0 + wave * 16 + i; const float rs = rsl[wave * 16 + i];
                const u32x2* xr = (const u32x2*)(X1B + (size_t)m * DM) + lane; u32x2* o8 = (u32x2*)(H2 + (size_t)m * DM) + lane;
#pragma unroll
                for (int j = 0; j < 4; ++j) { const int col = 256 * j + 4 * lane; const f32x4 gg = *(const f32x4*)(g2 + col), sc = *(const f32x4*)(md + 4096 + col), sh = *(const f32x4*)(md + 3072 + col);
                    const u32x2 xw = xr[64 * j]; const f32x4 xv = {bflo(xw.x), bfhi(xw.x), bflo(xw.y), bfhi(xw.y)};
                    const f32x4 h = xv * rs * gg * (sc + 1.0f) + sh; o8[64 * j] = (u32x2){pk2(h[0], h[1]), pk2(h[2], h[3])}; } }
            __syncthreads();
        }
    }
    SEAM(8);

    if (IN(9) || IN(10)) {
        if (tid0 == 0) { unsigned acc = 0; for (int e = 0; e < NEXP; ++e) { MISC[16 + e] = acc; acc += (__hip_atomic_load(ecnt + e * 64, RLX_AGENT) + 255u) >> 8; } MISC[16 + 32] = acc; MISC[16 + 33] = acc; }
        __syncthreads();
    }
    if (IN(9)) REP(9) {
        const int tid = opq(tid0);
        OrderMoe S{MISC + 16, ecnt, G, bx};
        const unsigned* list = (const unsigned*)(ws + WS_LIST); LAS unsigned* tokl = (LAS unsigned*)(L + TOKL_OFF);
        { Unit u; for (int i = 0; i < MAXU && S.next(i, u); ++i) if (tid < 256) tokl[i * 256 + tid] = (tid < u.cnt) ? (list[(size_t)u.e * ECAP + u.aux * 256 + tid] >> 1) : 0u; }
        __syncthreads();
        pg8::Gemm g{(const bf16_t*)(ws + WS_H2), (const bf16_t*)(ws + WS_W13), DM, DM};
        EpiMoe1 E{(bf16_t*)(ws + WS_HM)};
        pg8::gemm_phase<EpiMoe1, OrderMoe, true>(L, g, S, E, tokl);
        { const int lane = tid & 63; const int U = 4 * (int)MISC[16 + 33], rem = U % G, NL = G - rem; const bool spread = (NL >= G / 2);
            const int first = spread ? (bx >= rem ? bx - rem : -1) : bx, stride = spread ? NL : G;
            if (first >= 0) for (int it = first; it < NEXP * 32; it += stride) { const int e = it / 32, q = it % 32;
                wg_tile((const float*)KIN(I_W2) + (size_t)e * EFF * DM, DM, 64 * (q >> 2), 256 * (q & 3), (bf16_t*)(ws + WS_W2), EFF, e * 1024, 0, false, (LAS float*)L, wave, lane); }
        }
    }
    SEAM(9);
    if (IN(10)) REP(10) {
        OrderMoe S{MISC + 16, ecnt, G, bx};
        pg8::Gemm g{(const bf16_t*)(ws + WS_HM), (const bf16_t*)(ws + WS_W2), EFF, EFF};
        EpiMoe2 E{(const unsigned*)(ws + WS_LIST), (const float*)(ws + WS_LW), (bf16_t*)(ws + WS_Y)};
        pg8::gemm_phase<EpiMoe2, OrderMoe, false>(L, g, S, E, nullptr);
    }
    SEAM(10);

    if (IN(11)) REP(11) {
        const int tid = opq(tid0), lane = tid & 63; (void)tid;
        const bf16_t* Y = (const bf16_t*)(ws + WS_Y); const float* fg = (const float*)KIN(I_FG);
        for (int m = gw; m < NTOK; m += NGW) { const float* md = mod + (m / SEQ) * 6144 + 5120;
            const u32x2* xr = (const u32x2*)(ws + WS_X1B + (size_t)m * DM * 2) + lane; f32x4* xw = (f32x4*)(out + (size_t)m * DM) + lane; const u32x2* y0 = (const u32x2*)(Y + (size_t)(2 * m) * DM) + lane; const u32x2* y1 = (const u32x2*)(Y + (size_t)(2 * m + 1) * DM) + lane;
            f32x4 v[4]; float s = 0.f;
#pragma unroll
            for (int j = 0; j < 4; ++j) { const int col = 256 * j + 4 * lane; const u32x2 a = y0[64 * j], b = y1[64 * j]; const f32x4 g2 = *(const f32x4*)(md + col);
                const f32x4 ys = {bflo(a.x) + bflo(b.x), bfhi(a.x) + bfhi(b.x), bflo(a.y) + bflo(b.y), bfhi(a.y) + bfhi(b.y)};
                const u32x2 xq = xr[64 * j]; v[j] = (f32x4){bflo(xq.x), bfhi(xq.x), bflo(xq.y), bfhi(xq.y)} + g2 * ys; s += (v[j][0] * v[j][0] + v[j][1] * v[j][1]) + (v[j][2] * v[j][2] + v[j][3] * v[j][3]); }
            const float rs = 1.0f / sqrtf(wave_sum(s) * (1.f / DM) + EPS);
#pragma unroll
            for (int j = 0; j < 4; ++j) { const int col = 256 * j + 4 * lane; xw[64 * j] = v[j] * rs * *(const f32x4*)(fg + col); } }
    }
#undef IN
#undef SEAM
}

extern "C" void kernel_launch(void* const* d_in, const int* in_sizes, int n_in, void* d_out, int out_size, void* d_ws, size_t ws_size, hipStream_t stream) {
    static int grid = 0;
    if (grid == 0) {
        if (n_in != 27 || out_size != NTOK * DM || ws_size < WS_END) { fprintf(stderr, "kernel_launch: unexpected shapes (n_in %d, out %d, ws %zu)\n", n_in, out_size, ws_size); grid = -1; return; }
        int dev = 0, cus = 0;
        if (hipGetDevice(&dev) != hipSuccess || hipDeviceGetAttribute(&cus, hipDeviceAttributeMultiprocessorCount, dev) != hipSuccess) { grid = -1; return; }
        if (hipFuncSetAttribute((const void*)fwd_kernel, hipFuncAttributeMaxDynamicSharedMemorySize, LDS_BYTES) != hipSuccess) { fprintf(stderr, "kernel_launch: hipFuncSetAttribute failed\n"); grid = -1; return; }
        (void)hipGetLastError();
        grid = cus;
    }
    if (grid < 0) return;
    (void)hipMemsetAsync((char*)d_ws + WS_CTL, 0, CTL_ZERO_BYTES, stream);
    Args a{};
    for (int i = 0; i < 27; ++i) a.in[i] = d_in[i];
    a.out = (float*)d_out; a.ws = (unsigned char*)d_ws; a.dup = DUP_MASK; a.bar_rep = BAR_REP;
#if MK_ONE_LAUNCH
    a.ph_lo = 0; a.ph_hi = NPHASE;
    hipLaunchKernelGGL(fwd_kernel, dim3(grid), dim3(NWAVES * 64), LDS_BYTES, stream, a);
#else
    for (int p = 0; p < NPHASE; ++p) { a.ph_lo = p; a.ph_hi = p + 1; hipLaunchKernelGGL(fwd_kernel, dim3(grid), dim3(NWAVES * 64), LDS_BYTES, stream, a); }
#endif
}
```

```cpp
#include <hip/hip_runtime.h>
#include <hip/hip_bf16.h>
#include <cstdio>
#include <cstdint>
#include <cmath>

#ifndef MK_ONE_LAUNCH
#define MK_ONE_LAUNCH 1
#endif

#define LAS __attribute__((address_space(3)))
#define GAS __attribute__((address_space(1)))
typedef unsigned short bf16_t;
typedef short bf16x8 __attribute__((ext_vector_type(8)));
typedef short s16x4 __attribute__((ext_vector_type(4)));
typedef float f32x2 __attribute__((ext_vector_type(2)));
typedef float f32x4 __attribute__((ext_vector_type(4)));
typedef float f32x16 __attribute__((ext_vector_type(16)));
typedef unsigned u32x2 __attribute__((ext_vector_type(2)));
typedef unsigned u32x4 __attribute__((ext_vector_type(4)));
typedef __bf16 bf16x2_t __attribute__((ext_vector_type(2)));

__device__ __forceinline__ unsigned pk2(float lo, float hi) { f32x2 v = {lo, hi}; bf16x2_t b = __builtin_convertvector(v, bf16x2_t); return __builtin_bit_cast(unsigned, b); }
__device__ __forceinline__ float bflo(unsigned u) { return __uint_as_float(u << 16); }
__device__ __forceinline__ float bfhi(unsigned u) { return __uint_as_float(u & 0xffff0000u); }
__device__ __forceinline__ float bf2f(bf16_t h) { return __uint_as_float((unsigned)h << 16); }
__device__ __forceinline__ bf16_t f2bf(float f) { return (bf16_t)(pk2(f, 0.f) & 0xffffu); }
__device__ __forceinline__ float sigmoidf_(float x) { return __builtin_amdgcn_rcpf(1.0f + __builtin_amdgcn_exp2f(-1.4426950408889634f * x)); }
__device__ __forceinline__ float gelu_tanh(float x) { const float u = 0.7978845608028654f * (x + 0.044715f * x * x * x); return x * __builtin_amdgcn_rcpf(1.0f + __builtin_amdgcn_exp2f(-2.8853900817779268f * u)); }
#define DPPF(v, ctrl, rmask) __uint_as_float(__builtin_amdgcn_update_dpp(0u, __float_as_uint(v), ctrl, rmask, 0xF, false))
__device__ __forceinline__ float wave_sum(float v) {
    v += DPPF(v, 0xB1, 0xF);
    v += DPPF(v, 0x4E, 0xF);
    v += DPPF(v, 0x141, 0xF);
    v += DPPF(v, 0x140, 0xF);
    v += DPPF(v, 0x142, 0xA);
    v += DPPF(v, 0x143, 0xC);
    return __uint_as_float(__builtin_amdgcn_readlane(__float_as_uint(v), 63));
}
__device__ __forceinline__ int opq(int x) { asm volatile("" : "+v"(x)); return x; }
#define LDS_WAIT() asm volatile("s_waitcnt lgkmcnt(0)" ::: "memory")
#define VM_WAIT() asm volatile("s_waitcnt vmcnt(0)" ::: "memory")

constexpr int NB = 2, SEQ = 16384, NTOK = NB * SEQ, DM = 1024;
constexpr int NH = 8, DQK = 96, QW = NH * DQK  ;
constexpr int INW = 3488, NPROJ = 3584;
constexpr int NEXP = 32, EFF = 512, ECAP = 32768;
constexpr float EPS = 1e-6f;
constexpr float C2 = 0.10206207261596577f * 1.4426950408889634f;
constexpr int NWAVES = 8;
constexpr int W13_TILES = 2048;

constexpr size_t MiB = 1u << 20;
constexpr size_t WS_CTL = 0, CTL_ZERO_BYTES = 65536;
constexpr int CW_TMO = 0, CW_BAR = 4096, CW_CNT = 8192, CW_MODRDY = 12288, CW_WQ = 12352, CW_ADONE = 12416, CW_W2Q = 12480;
constexpr size_t WS_MOD = 65536;
constexpr size_t WS_SSQQ = 2 * MiB, WS_SSQKV = 3 * MiB;
constexpr size_t WS_BIASP = 65536 + 49152;
constexpr size_t WS_WPH = 1 * MiB + 512 * 1024, WS_WPL = 1 * MiB + 768 * 1024;
constexpr size_t WS_WSTRIL = 1 * MiB;
constexpr size_t WS_CS = 4 * MiB;
constexpr size_t WS_LIST = 8 * MiB, WS_LW = 12 * MiB;
constexpr size_t WS_W13 = 16 * MiB, WS_W2 = 80 * MiB, WS_WIN = 112 * MiB, WS_WOUT = 119 * MiB, WS_WBR = 121 * MiB, WS_WUP = 123 * MiB;
constexpr size_t WS_GATES = 128 * MiB, WS_AS = 256 * MiB, WS_SGUV = 320 * MiB, WS_CQKV = 466 * MiB, WS_XN = 352 * MiB;
constexpr size_t WS_Q = 352 * MiB, WS_KN = 400 * MiB, WS_V = 432 * MiB, WS_KPE = 464 * MiB;
constexpr size_t WS_X1B = 416 * MiB;
constexpr size_t WS_MERGED = 352 * MiB, WS_H2 = 128 * MiB, WS_HM = 192 * MiB, WS_Y = 264 * MiB, WS_END = 512 * MiB;
static_assert(WS_Y + (size_t)2 * NTOK * DM * 2 + DM * 2 <= WS_X1B && WS_Y + (size_t)2 * NTOK * DM * 2 >= WS_MERGED, "dump row");

constexpr int RING_BYTES = 131072;
constexpr int MISC_OFF = RING_BYTES;
constexpr int TOKL_OFF = RING_BYTES + 1024;
constexpr int MAXU = 6;
constexpr int LDS_BYTES = 147456;
static_assert(TOKL_OFF + MAXU * 1024 <= LDS_BYTES, "LDS map");

namespace pg8 {
constexpr int BM = 256, BK = 64, HALF = 128, HTB = HALF * BK * 2, STAGE_BYTES = 8 * HTB, NXCD = 8, WGM = 8;
__host__ __device__ __forceinline__ int lds_byte(int r, int c) { const int st = (r >> 4) * 2 + (c >> 5), rr = r & 15, cc = c & 31, ob = rr * 64 + cc * 2; return st * 1024 + (ob ^ (((ob >> 9) & 1) << 5)); }
__host__ __device__ __forceinline__ void stage_rc(int b, int& R, int& C) { const int st = b / 1024, sb = b % 1024, swz = sb ^ (((sb >> 9) & 1) << 5); R = (st >> 1) * 16 + swz / 64; C = (st & 1) * 32 + (swz % 64) / 2; }
__host__ __device__ __forceinline__ int perm32(int rho) { const int n = rho >> 4, i = rho & 15; return 8 * (i >> 2) + 4 * n + (i & 3); }

struct Unit { int arow, acol, brow, pm, pn, e, cnt, aux, roff, nai; };
struct Gemm { const bf16_t* A; const bf16_t* Bt; int lda, K; };

struct GridMap {
    int nM, nN, nwg;
    __device__ __forceinline__ void init(int nM_, int nN_) { nM = nM_; nN = nN_; nwg = nM_ * nN_; }
    __device__ __forceinline__ bool map(long L, int& pm, int& pn) const {
        if (L >= nwg) return false;
        int wgid = (int)L; { const int q = nwg / NXCD, r = nwg % NXCD, xcd = wgid % NXCD, off = wgid / NXCD; wgid = (xcd < r ? xcd * (q + 1) : r * (q + 1) + (xcd - r) * q) + off; }
        const int nig = WGM * nN, gid = wgid / nig, fm = gid * WGM, gsz = (nM - fm) < WGM ? (nM - fm) : WGM;
        pm = fm + ((wgid % nig) % gsz); pn = (wgid % nig) / gsz; return true;
    }
};

template <class Epi, class Sched, bool GATHER, bool HALFM = false>
__device__ __forceinline__ void gemm_phase(LAS unsigned char* lds, const Gemm g, const Sched& S, const Epi& E, const LAS unsigned* tokl) {
    const int tid = opq(threadIdx.x), wid = __builtin_amdgcn_readfirstlane(tid >> 6), lane = tid & 63, wr = wid >> 2, wc = wid & 3, fr = lane & 15, fq = lane >> 4;
    const int K = g.K, nt = K / BK, lda = g.lda;
    unsigned voffB[2], vA0c[2], vA1c[2], vA0n[2], vA1n[2]; int Rr[2]; unsigned Cb[2];
#pragma unroll
    for (int i = 0; i < 2; ++i) { int R, C; stage_rc(tid * 16 + i * 8192, R, C); const int Rb = Epi::WIDE ? (64 * (R >> 5) + perm32(R & 31)) : Epi::PERM ? ((R & ~31) + perm32(R & 31)) : R;
        voffB[i] = (unsigned)(Rb * K + C) * 2u; Rr[i] = R; Cb[i] = (unsigned)C * 2u;
        vA0c[i] = (unsigned)(R * lda + C) * 2u; vA1c[i] = vA0c[i] + (HALFM ? 0u : (unsigned)(HALF * lda) * 2u); vA0n[i] = vA0c[i]; vA1n[i] = vA1c[i]; }
    const size_t kstep = (size_t)(BK * 2);
    const size_t hstepB = (size_t)(Epi::WIDE ? 32 : HALF) * K * 2;
    const unsigned ldsw = (unsigned)wid * 1024u;
    const int aoff = lds_byte(wr * 64 + fr, fq * 8), boff = lds_byte(wc * 32 + fr, fq * 8);
#define PG8_SA(b, h) (((b) * 2 + (h)) * HTB)
#define PG8_SB(b, h) ((4 + (b) * 2 + (h)) * HTB)
#define PG8_STAGE(bufoff, gbase, voff) do { _Pragma("unroll") for (int _i = 0; _i < 2; ++_i) \
        __builtin_amdgcn_global_load_lds((const unsigned*)((const char*)(gbase) + (voff)[_i]), (LAS unsigned*)(lds + (bufoff) + ldsw + _i * 8192), 16, 0, 0); } while (0)
#define PG8_LDA(dst, b, h) do { _Pragma("unroll") for (int m = 0; m < 4; ++m) _Pragma("unroll") for (int k = 0; k < 2; ++k) dst[m][k] = *(const LAS bf16x8*)(lds + PG8_SA(b, h) + aoff + m * 2048 + k * 1024); } while (0)
#define PG8_LDB(dst, b, h) do { _Pragma("unroll") for (int n = 0; n < 2; ++n) _Pragma("unroll") for (int k = 0; k < 2; ++k) dst[n][k] = *(const LAS bf16x8*)(lds + PG8_SB(b, h) + boff + n * 2048 + k * 1024); } while (0)
#define PG8_MMA(ai, bj, At, Bt) do { __builtin_amdgcn_s_setprio(1); _Pragma("unroll") for (int m = 0; m < 4; ++m) _Pragma("unroll") for (int n = 0; n < 2; ++n) _Pragma("unroll") for (int k = 0; k < 2; ++k) \
        acc[ai][bj][m][n] = __builtin_amdgcn_mfma_f32_16x16x32_bf16(Bt[n][k], At[m][k], acc[ai][bj][m][n], 0, 0, 0); __builtin_amdgcn_s_setprio(0); } while (0)
#define PG8_WAIT_V(n) asm volatile("s_waitcnt vmcnt(" #n ")" ::: "memory")
#define PG8_WAIT_L(n) asm volatile("s_waitcnt lgkmcnt(" #n ")" ::: "memory")
#define PG8_BAR __builtin_amdgcn_s_barrier()
#define PG8_SCHED __builtin_amdgcn_sched_barrier(0)
    Unit cur, nxt; int ui = 0;
    if (!S.next(0, cur)) return;
    f32x4 acc[2][2][4][2];
#pragma unroll
    for (int a = 0; a < 2; ++a)
#pragma unroll
        for (int b = 0; b < 2; ++b)
#pragma unroll
            for (int m = 0; m < 4; ++m)
#pragma unroll
                for (int n = 0; n < 2; ++n) acc[a][b][m][n] = (f32x4){0.f, 0.f, 0.f, 0.f};
    bf16x8 At[4][2], B0[2][2], B1[2][2];
    if constexpr (GATHER) {
#pragma unroll
        for (int i = 0; i < 2; ++i) { vA0c[i] = tokl[Rr[i]] * (unsigned)(lda * 2) + Cb[i]; vA1c[i] = HALFM ? vA0c[i] : tokl[HALF + Rr[i]] * (unsigned)(lda * 2) + Cb[i]; }
    }
    const char* cA = GATHER ? (const char*)g.A : (const char*)g.A + ((size_t)cur.arow * lda + cur.acol) * 2;
    const char* cB = (const char*)g.Bt + (size_t)cur.brow * K * 2;
    PG8_STAGE(PG8_SB(0, 0), cB, voffB); PG8_STAGE(PG8_SB(0, 1), cB + hstepB, voffB); PG8_STAGE(PG8_SA(0, 0), cA, vA0c); PG8_STAGE(PG8_SA(0, 1), cA, vA1c);
    if (wr == 1) PG8_BAR;
    PG8_WAIT_V(2); PG8_BAR;
    PG8_STAGE(PG8_SB(1, 0), cB + kstep, voffB); PG8_STAGE(PG8_SA(1, 0), cA + kstep, vA0c); PG8_STAGE(PG8_SB(1, 1), cB + hstepB + kstep, voffB);
    PG8_WAIT_V(6); PG8_BAR;
    for (;;) {
        const bool has_next = S.next(ui + 1, nxt);
        const char* nA = cA; const char* nB = cB;
        if (has_next) { nA = GATHER ? (const char*)g.A : (const char*)g.A + ((size_t)nxt.arow * lda + nxt.acol) * 2; nB = (const char*)g.Bt + (size_t)nxt.brow * K * 2; }
        if constexpr (GATHER) {
            if (has_next) {
#pragma unroll
                for (int i = 0; i < 2; ++i) { vA0n[i] = tokl[(ui + 1) * 256 + Rr[i]] * (unsigned)(lda * 2) + Cb[i]; vA1n[i] = tokl[(ui + 1) * 256 + HALF + Rr[i]] * (unsigned)(lda * 2) + Cb[i]; }
            } else {
#pragma unroll
                for (int i = 0; i < 2; ++i) { vA0n[i] = vA0c[i]; vA1n[i] = vA1c[i]; }
            }
        }
#pragma unroll 1
        for (int t = 0; t < nt; t += 2) {
            const bool last = (t == nt - 2);
            if constexpr (Epi::HAS_MID) { if (t == (nt >> 1)) E.mid(acc, cur, wr, wc, fr, fq); }
            const char* a1 = cA + (size_t)(t + 1) * kstep;
            const char* a2 = last ? nA : cA + (size_t)(t + 2) * kstep; const char* b2 = last ? nB : cB + (size_t)(t + 2) * kstep;
            const char* a3 = a2 + kstep; const char* b3 = b2 + kstep;
            unsigned s0[2], s1[2];
#pragma unroll
            for (int i = 0; i < 2; ++i) { s0[i] = (GATHER && last) ? vA0n[i] : vA0c[i]; s1[i] = (GATHER && last) ? vA1n[i] : vA1c[i]; }
            PG8_LDB(B0, 0, 0); PG8_LDB(B1, 0, 1); PG8_SCHED; PG8_LDA(At, 0, 0); PG8_STAGE(PG8_SA(1, 1), a1, vA1c);
            PG8_WAIT_V(8); PG8_WAIT_L(0); PG8_BAR; PG8_MMA(0, 0, At, B0); PG8_MMA(0, 1, At, B1); PG8_BAR; PG8_SCHED;
            if constexpr (!HALFM) PG8_LDA(At, 0, 1);
            PG8_STAGE(PG8_SB(0, 0), b2, voffB); PG8_STAGE(PG8_SB(0, 1), b2 + hstepB, voffB); PG8_STAGE(PG8_SA(0, 0), a2, s0);
            PG8_WAIT_V(8); PG8_WAIT_L(0); PG8_BAR; if constexpr (!HALFM) { PG8_MMA(1, 0, At, B0); PG8_MMA(1, 1, At, B1); } PG8_BAR; PG8_SCHED;
            PG8_LDB(B0, 1, 0); PG8_LDB(B1, 1, 1); PG8_SCHED; PG8_LDA(At, 1, 0); PG8_STAGE(PG8_SA(0, 1), a2, s1);
            PG8_WAIT_V(8); PG8_WAIT_L(0); PG8_BAR; PG8_MMA(0, 0, At, B0); PG8_MMA(0, 1, At, B1); PG8_BAR; PG8_SCHED;
            if constexpr (!HALFM) PG8_LDA(At, 1, 1);
            PG8_STAGE(PG8_SB(1, 0), b3, voffB); PG8_STAGE(PG8_SB(1, 1), b3 + hstepB, voffB); PG8_STAGE(PG8_SA(1, 0), a3, s0);
            PG8_WAIT_V(8); PG8_WAIT_L(0); PG8_BAR; if constexpr (!HALFM) { PG8_MMA(1, 0, At, B0); PG8_MMA(1, 1, At, B1); } PG8_BAR; PG8_SCHED;
        }
        if (wr == 0) PG8_BAR;
        E(acc, cur, wr, wc, fr, fq);
        if (!has_next) break;
#pragma unroll
        for (int a = 0; a < 2; ++a)
#pragma unroll
            for (int b = 0; b < 2; ++b)
#pragma unroll
                for (int m = 0; m < 4; ++m)
#pragma unroll
                    for (int n = 0; n < 2; ++n) acc[a][b][m][n] = (f32x4){0.f, 0.f, 0.f, 0.f};
        cur = nxt; cA = nA; cB = nB; ++ui;
        if constexpr (GATHER) {
#pragma unroll
            for (int i = 0; i < 2; ++i) { vA0c[i] = vA0n[i]; vA1c[i] = vA1n[i]; }
        }
        if (wr == 1) PG8_BAR;
    }
    PG8_WAIT_V(0);
    PG8_BAR;
#undef PG8_SA
#undef PG8_SB
#undef PG8_STAGE
#undef PG8_LDA
#undef PG8_LDB
#undef PG8_MMA
#undef PG8_WAIT_V
#undef PG8_WAIT_L
#undef PG8_BAR
#undef PG8_SCHED
}
}
using pg8::Unit;

__device__ __forceinline__ u32x4 pack8(const f32x4& a, const f32x4& b) { u32x4 w; w.x = pk2(a[0], a[1]); w.y = pk2(a[2], a[3]); w.z = pk2(b[0], b[1]); w.w = pk2(b[2], b[3]); return w; }

struct EpiProj {
    static constexpr bool PERM = true, HAS_MID = false, WIDE = false;
    bf16_t *cqkv, *as_u, *sguv, *gates; float *ssqq, *ssqkv;
    __device__ __forceinline__ void operator()(const f32x4 (&acc)[2][2][4][2], const Unit& u, int wr, int wc, int fr, int fq) const {
        fr = opq(fr); fq = opq(fq);
        const int pn = u.pn, row0 = u.pm * 256 + wr * 64 + fr;
        if (pn >= 6) {
            const int col = 128 * (pn - 6) + 32 * wc + 8 * fq;
#pragma unroll
            for (int ai = 0; ai < 2; ++ai)
#pragma unroll
                for (int m = 0; m < 4; ++m) { f32x4 r0, r1, s0, s1;
#pragma unroll
                    for (int j = 0; j < 4; ++j) { const float ea0 = __builtin_amdgcn_exp2f(-1.4426950408889634f * __builtin_amdgcn_fmed3f(acc[ai][0][m][0][j], -60.f, 60.f)), eb0 = __builtin_amdgcn_exp2f(-1.4426950408889634f * __builtin_amdgcn_fmed3f(acc[ai][1][m][0][j], -60.f, 60.f));
                        const float ea1 = __builtin_amdgcn_exp2f(-1.4426950408889634f * __builtin_amdgcn_fmed3f(acc[ai][0][m][1][j], -60.f, 60.f)), eb1 = __builtin_amdgcn_exp2f(-1.4426950408889634f * __builtin_amdgcn_fmed3f(acc[ai][1][m][1][j], -60.f, 60.f));
                        s0[j] = __builtin_amdgcn_rcpf(1.0f + eb0); s1[j] = __builtin_amdgcn_rcpf(1.0f + eb1);
                        r0[j] = (1.0f + eb0) * __builtin_amdgcn_rcpf(1.0f + ea0); r1[j] = (1.0f + eb1) * __builtin_amdgcn_rcpf(1.0f + ea1); }
                    bf16_t* rowp = gates + (size_t)(row0 + ai * 128 + m * 16) * 2048 + col;
                    __builtin_nontemporal_store(pack8(r0, r1), (u32x4*)rowp); __builtin_nontemporal_store(pack8(s0, s1), (u32x4*)(rowp + 1024)); }
            return;
        }
        bf16_t* base; int ld, act, colt;
        if (pn < 2) { base = cqkv; ld = 512; act = 0; colt = pn * 256; }
        else if (pn < 4) { base = as_u; ld = 1024; act = 1; colt = (pn - 2) * 256; }
        else { base = sguv; ld = 512; act = 1; colt = (pn - 4) * 256; }
        const int col0 = colt + wc * 32 + 8 * fq;
#pragma unroll
        for (int ai = 0; ai < 2; ++ai)
#pragma unroll
            for (int m = 0; m < 4; ++m) {
                const int row = row0 + ai * 128 + m * 16; bf16_t* rowp = base + (size_t)row * ld + col0; float ss = 0.f;
#pragma unroll
                for (int bj = 0; bj < 2; ++bj) { f32x4 v0 = acc[ai][bj][m][0], v1 = acc[ai][bj][m][1];
                    if (act == 0) { if (pn == 0 || bj == 0) ss += (v0[0] * v0[0] + v0[1] * v0[1]) + (v0[2] * v0[2] + v0[3] * v0[3]) + (v1[0] * v1[0] + v1[1] * v1[1]) + (v1[2] * v1[2] + v1[3] * v1[3]); }
                    else {
#pragma unroll
                        for (int j = 0; j < 4; ++j) { v0[j] = gelu_tanh(v0[j]); v1[j] = gelu_tanh(v1[j]); } }
                    *(u32x4*)(rowp + bj * 128) = pack8(v0, v1); }
                if (pn < 2) { ss += __shfl_xor(ss, 16); ss += __shfl_xor(ss, 32);
                    if (fq == 0) (pn == 0 ? ssqq : ssqkv)[(size_t)row * 4 + wc] = ss; }
            }
    }
};

struct EpiUp {
    static constexpr bool PERM = true, HAS_MID = false, WIDE = true;
    bf16_t *q, *kn, *v; const float *ssqq, *ssqkv; const f32x4* cs;
    __device__ __forceinline__ void operator()(const f32x4 (&acc)[2][2][4][2], const Unit& u, int wr, int wc, int fr, int fq) const {
        fr = opq(fr); fq = opq(fq);
        const int pn = u.pn, row0 = u.pm * 256 + wr * 64 + fr;
#pragma unroll
        for (int ai = 0; ai < 2; ++ai)
#pragma unroll
            for (int m = 0; m < 4; ++m) {
                const int row = row0 + ai * 128 + m * 16;
                if (pn < 3) {
                    const f32x4 sp = *(const f32x4*)(ssqq + (size_t)row * 4); const float rs = 1.0f / sqrtf(((sp[0] + sp[1]) + (sp[2] + sp[3])) * (1.0f / 256.0f) + EPS);
#pragma unroll
                    for (int bj = 0; bj < 2; ++bj) { const int gg = 8 * pn + 2 * wc + bj, col = 256 * pn + 64 * wc + 32 * bj + 8 * fq;
                        f32x4 v0 = acc[ai][bj][m][0] * rs, v1 = acc[ai][bj][m][1] * rs;
                        if (gg % 3 == 2) { const f32x4 c01 = cs[(size_t)row * 8 + 2 * fq], c23 = cs[(size_t)row * 8 + 2 * fq + 1];
                            const float cc[4] = {c01[0], c01[2], c23[0], c23[2]}, sn[4] = {c01[1], c01[3], c23[1], c23[3]};
#pragma unroll
                            for (int j = 0; j < 4; ++j) { const float x1 = v0[j], x2 = v1[j]; v0[j] = x1 * cc[j] - x2 * sn[j]; v1[j] = x1 * sn[j] + x2 * cc[j]; } }
                        *(u32x4*)(q + (size_t)row * QW + col) = pack8(v0, v1); }
                } else {
                    const f32x4 sp = *(const f32x4*)(ssqkv + (size_t)row * 4); const float rs = 1.0f / sqrtf(((sp[0] + sp[1]) + (sp[2] + sp[3])) * (1.0f / 128.0f) + EPS);
#pragma unroll
                    for (int bj = 0; bj < 2; ++bj) { const int h = 2 * (pn - 3) + (wc >> 1), cc = 32 * bj + 8 * fq;
                        bf16_t* dst = ((wc & 1) == 0) ? kn + (size_t)row * 512 + h * 64 + cc : v + (size_t)row * 512 + h * 64 + cc;
                        *(u32x4*)dst = pack8(acc[ai][bj][m][0] * rs, acc[ai][bj][m][1] * rs); }
                }

            }
    }
};

struct EpiBranch {
    static constexpr bool PERM = true, HAS_MID = true, WIDE = true;
    const bf16_t* gates; bf16_t* merged;
    __device__ __forceinline__ void scale(f32x4 (&acc)[2][2][4][2], const Unit& u, int wr, int wc, int fr, int fq, int goff) const {
        const int row0 = u.pm * 256 + wr * 64 + fr;
#pragma unroll
        for (int ai = 0; ai < 2; ++ai)
#pragma unroll
            for (int m = 0; m < 4; ++m) { const int row = row0 + ai * 128 + m * 16;
#pragma unroll
                for (int bj = 0; bj < 2; ++bj) { const int col = 256 * u.pn + 64 * wc + 32 * bj + 8 * fq;
                    const u32x4 gw = *(const u32x4*)(gates + (size_t)row * 2048 + goff + col);
                    f32x4& v0 = acc[ai][bj][m][0]; f32x4& v1 = acc[ai][bj][m][1];
                    v0[0] *= bflo(gw.x); v0[1] *= bfhi(gw.x); v0[2] *= bflo(gw.y); v0[3] *= bfhi(gw.y); v1[0] *= bflo(gw.z); v1[1] *= bfhi(gw.z); v1[2] *= bflo(gw.w); v1[3] *= bfhi(gw.w); } }
    }
    __device__ __forceinline__ void mid(f32x4 (&acc)[2][2][4][2], const Unit& u, int wr, int wc, int fr, int fq) const { fr = opq(fr); fq = opq(fq); scale(acc, u, wr, wc, fr, fq, 0); }
    __device__ __forceinline__ void operator()(f32x4 (&acc)[2][2][4][2], const Unit& u, int wr, int wc, int fr, int fq) const {
        fr = opq(fr); fq = opq(fq);
        const int row0 = u.pm * 256 + wr * 64 + fr, colb = 256 * u.pn + 64 * wc + 8 * fq;
        u32x4 gq[2][2][2];
#define EPB_LOAD(buf, qi) do { _Pragma("unroll") for (int mm = 0; mm < 2; ++mm) _Pragma("unroll") for (int bj = 0; bj < 2; ++bj) \
            gq[buf][mm][bj] = *(const u32x4*)(gates + (size_t)(row0 + ((qi) >> 1) * 128 + (2 * ((qi) & 1) + mm) * 16) * 2048 + 1024 + colb + 32 * bj); } while (0)
#define EPB_STORE(buf, qi) do { _Pragma("unroll") for (int mm = 0; mm < 2; ++mm) _Pragma("unroll") for (int bj = 0; bj < 2; ++bj) { const int ai = (qi) >> 1, m = 2 * ((qi) & 1) + mm; const u32x4 gw = gq[buf][mm][bj]; \
            f32x4 v0 = acc[ai][bj][m][0], v1 = acc[ai][bj][m][1]; \
            v0[0] *= bflo(gw.x); v0[1] *= bfhi(gw.x); v0[2] *= bflo(gw.y); v0[3] *= bfhi(gw.y); v1[0] *= bflo(gw.z); v1[1] *= bfhi(gw.z); v1[2] *= bflo(gw.w); v1[3] *= bfhi(gw.w); \
            *(u32x4*)(merged + (size_t)(row0 + ai * 128 + m * 16) * 1024 + colb + 32 * bj) = pack8(v0, v1); } } while (0)
        EPB_LOAD(0, 0); EPB_LOAD(1, 1);
        EPB_STORE(0, 0); EPB_LOAD(0, 2);
        EPB_STORE(1, 1); EPB_LOAD(1, 3);
        EPB_STORE(0, 2);
        EPB_STORE(1, 3);
#undef EPB_LOAD
#undef EPB_STORE
    }
};

struct EpiOut {
    static constexpr bool PERM = true, HAS_MID = false, WIDE = true;
    const float* x; const float* mod; bf16_t* x1b;
    __device__ __forceinline__ void operator()(const f32x4 (&acc)[2][2][4][2], const Unit& u, int wr, int wc, int fr, int fq) const {
        fr = opq(fr); fq = opq(fq);
        const int row0 = u.pm * 256 + wr * 64 + fr, col0 = u.pn * 256 + wc * 64 + 8 * fq; const float* g1 = mod + (u.pm >> 6) * 6144 + 2048;
        f32x4 gv[2][2];
#pragma unroll
        for (int bj = 0; bj < 2; ++bj)
#pragma unroll
            for (int n = 0; n < 2; ++n) gv[bj][n] = *(const f32x4*)(g1 + col0 + bj * 32 + n * 4);
        f32x4 xa[2][2][2], xb[2][2][2];
#define EPO_LOAD(buf, qi) do { _Pragma("unroll") for (int mm = 0; mm < 2; ++mm) _Pragma("unroll") for (int bj = 0; bj < 2; ++bj) { \
            const size_t off = (size_t)(row0 + ((qi) >> 1) * 128 + (2 * ((qi) & 1) + mm) * 16) * DM + col0 + bj * 32; xa[buf][mm][bj] = *(const f32x4*)(x + off); xb[buf][mm][bj] = *(const f32x4*)(x + off + 4); } } while (0)
#define EPO_STORE(buf, qi) do { _Pragma("unroll") for (int mm = 0; mm < 2; ++mm) _Pragma("unroll") for (int bj = 0; bj < 2; ++bj) { const int ai = (qi) >> 1, m = 2 * ((qi) & 1) + mm; \
            const size_t off = (size_t)(row0 + ai * 128 + m * 16) * DM + col0 + bj * 32; \
            *(u32x4*)(x1b + off) = pack8(xa[buf][mm][bj] + gv[bj][0] * acc[ai][bj][m][0], xb[buf][mm][bj] + gv[bj][1] * acc[ai][bj][m][1]); } } while (0)
        EPO_LOAD(0, 0); EPO_LOAD(1, 1);
        EPO_STORE(0, 0); EPO_LOAD(0, 2);
        EPO_STORE(1, 1); EPO_LOAD(1, 3);
        EPO_STORE(0, 2);
        EPO_STORE(1, 3);
#undef EPO_LOAD
#undef EPO_STORE
    }
};

struct EpiMoe1 {
    static constexpr bool PERM = true, HAS_MID = false, WIDE = false;
    bf16_t* hm;
    __device__ __forceinline__ void operator()(const f32x4 (&acc)[2][2][4][2], const Unit& u, int wr, int wc, int fr, int fq) const {
        fr = opq(fr); fq = opq(fq);
        const int row0 = u.pm * 256 + u.roff + wr * 64 + fr, col = 128 * u.pn + 32 * wc + 8 * fq;
#pragma unroll
        for (int ai = 0; ai < 2; ++ai) if (ai < u.nai)
#pragma unroll
            for (int m = 0; m < 4; ++m) { f32x4 h0, h1;
#pragma unroll
                for (int j = 0; j < 4; ++j) { const float a0 = acc[ai][0][m][0][j], a1 = acc[ai][0][m][1][j]; h0[j] = a0 * sigmoidf_(a0) * acc[ai][1][m][0][j]; h1[j] = a1 * sigmoidf_(a1) * acc[ai][1][m][1][j]; }
                *(u32x4*)(hm + (size_t)(row0 + ai * 128 + m * 16) * EFF + col) = pack8(h0, h1); }
    }
};

struct EpiMoe2 {
    static constexpr bool PERM = true, HAS_MID = false, WIDE = true;
    const unsigned* list; const float* lw; bf16_t* y;
    __device__ __forceinline__ void operator()(const f32x4 (&acc)[2][2][4][2], const Unit& u, int wr, int wc, int fr, int fq) const {
        fr = opq(fr); fq = opq(fq);
        unsigned tk[2][4]; float w[2][4];
#pragma unroll
        for (int ai = 0; ai < 2; ++ai)
#pragma unroll
            for (int m = 0; m < 4; ++m) { const int r = u.roff + ai * 128 + wr * 64 + m * 16 + fr; const bool ok = (r < u.cnt) && (ai < u.nai); const size_t idx = (size_t)u.e * ECAP + u.aux * 256 + (ok ? r : 0); const unsigned t_ = list[idx]; w[ai][m] = lw[idx];
                tk[ai][m] = ok ? t_ : (unsigned)(2 * NTOK); }
#pragma unroll
        for (int ai = 0; ai < 2; ++ai) if (ai < u.nai)
#pragma unroll
            for (int m = 0; m < 4; ++m)
#pragma unroll
                for (int bj = 0; bj < 2; ++bj) *(u32x4*)(y + (size_t)tk[ai][m] * DM + 256 * u.pn + 64 * wc + 32 * bj + 8 * fq) = pack8(acc[ai][bj][m][0] * w[ai][m], acc[ai][bj][m][1] * w[ai][m]);
    }
};

struct OrderGrid {
    pg8::GridMap gm; int G, c, split_pn, acol_hi;
    __device__ __forceinline__ bool next(int i, Unit& u) const { int pm, pn; if (!gm.map((long)i * G + c, pm, pn)) return false;
        u.pm = pm; u.pn = pn; u.arow = pm * 256; u.acol = (pn >= split_pn) ? acol_hi : 0; u.brow = pn * 256; u.e = 0; u.cnt = 256; u.aux = 0; u.roff = 0; u.nai = 2; return true; }
};
struct OrderBranch {
    pg8::GridMap gm; int G, c;
    __device__ __forceinline__ bool next(int i, Unit& u) const { int pm, pn; if (!gm.map((long)(i >> 1) * G + c, pm, pn)) return false; const int br = i & 1;
        u.pm = pm; u.pn = pn; u.arow = pm * 256; u.acol = br * 512; u.brow = br * 1024 + pn * 256; u.e = br; u.cnt = 256; u.aux = 0; u.roff = 0; u.nai = 2; return true; }
};
struct OrderMoe {
    const volatile LAS unsigned* tp; const unsigned* cnt; int G, c, nfull;
    __device__ __forceinline__ bool at(long L, Unit& u) const {
        const int T = (int)tp[33], nwg = 4 * T; if (L >= nwg) return false;
        int wgid = (int)L; { const int q = nwg / 8, r = nwg % 8, xcd = wgid % 8, off = wgid / 8; wgid = (xcd < r ? xcd * (q + 1) : r * (q + 1) + (xcd - r) * q) + off; }
        const int ti = wgid >> 2, pn = wgid & 3; int e = 0;
        for (int j = 1; j < NEXP; ++j) if ((int)tp[j] <= ti) e = j;
        const int tile = ti - (int)tp[e]; int rem = (int)__hip_atomic_load(cnt + e * 64, __ATOMIC_RELAXED, __HIP_MEMORY_SCOPE_AGENT) - tile * 256; rem = rem > 256 ? 256 : rem;
        u.pm = ti; u.pn = pn; u.arow = ti * 256; u.acol = 0; u.brow = e * 1024 + pn * 256; u.e = e; u.cnt = rem; u.aux = tile; u.roff = 0; u.nai = 2; return true; }
    __device__ __forceinline__ bool next(int i, Unit& u) const { if (i >= nfull) return false; return at((long)i * G + c, u); }
};
struct OrderOne {
    Unit u0;
    __device__ __forceinline__ bool next(int i, Unit& u) const { if (i != 0) return false; u = u0; return true; }
};

namespace attn {
#define SBAR() __builtin_amdgcn_sched_barrier(0)
__device__ __forceinline__ int crow(int r, int hi) { return (r & 3) + 8 * (r >> 2) + 4 * hi; }
constexpr int KSLOT = 12288, VSLOT = 8192;
constexpr int LDS_K = 0, LDS_V = 2 * KSLOT, LDS_WS = LDS_V + 2 * VSLOT, LDS_OST = LDS_WS + NWAVES * 64 * 4, LDS_END = LDS_OST + NWAVES * 4096;
static_assert(LDS_END <= RING_BYTES, "attention LDS");
__device__ __forceinline__ void glds16(const void* gsrc, unsigned lds_dst) { unsigned keep;
    asm volatile("s_mov_b32 %0, m0\n\ts_mov_b32 m0, %2\n\ts_nop 0\n\tglobal_load_lds_dwordx4 %1, off\n\ts_mov_b32 m0, %0" : "=&s"(keep) : "v"(gsrc), "s"(lds_dst) : "memory"); }
__device__ __forceinline__ void cmask(f32x16& p0, f32x16& p1, int jb, int qrel, int hi) {
    const float NEG = -INFINITY; const int kb = 64 * jb + 4 * hi;
#pragma unroll
    for (int r = 0; r < 16; ++r) { const int kv = kb + (r & 3) + 8 * (r >> 2); if (kv > qrel) p0[r] = NEG; if (kv + 32 > qrel) p1[r] = NEG; }
}
__device__ __forceinline__ void qkt(f32x16& p0, f32x16& p1, const char* Kslot, const bf16x8* qr, int r32, int hi) {
    const char* kb = Kslot + hi * 1024 + r32 * 16;
    p0 = f32x16{}; p1 = f32x16{};
#pragma unroll
    for (int d0 = 0; d0 < 6; ++d0) {
        const bf16x8 b0 = *reinterpret_cast<const bf16x8*>(kb + d0 * 2048);
        const bf16x8 b1 = *reinterpret_cast<const bf16x8*>(kb + d0 * 2048 + 512);
        p0 = __builtin_amdgcn_mfma_f32_32x32x16_bf16(b0, qr[d0], p0, 0, 0, 0); p1 = __builtin_amdgcn_mfma_f32_32x32x16_bf16(b1, qr[d0], p1, 0, 0, 0); }
}
__device__ __forceinline__ void pv(f32x16* o, int vb, bf16x8 pa0, bf16x8 pa1, bf16x8 pa2, bf16x8 pa3) {
#pragma unroll
    for (int d0 = 0; d0 < 2; ++d0) { s16x4 lo[4], hi[4];
#pragma unroll
        for (int ks = 0; ks < 4; ++ks) {
            asm volatile("ds_read_b64_tr_b16 %0,%1 offset:%c2" : "=&v"(lo[ks]) : "v"(vb), "i"(d0 * 4096 + ks * 1024) : "memory");
            asm volatile("ds_read_b64_tr_b16 %0,%1 offset:%c2" : "=&v"(hi[ks]) : "v"(vb), "i"(d0 * 4096 + ks * 1024 + 512) : "memory"); }
        asm volatile("s_waitcnt lgkmcnt(0)" ::: "memory"); SBAR();
#define PK(k) (bf16x8){lo[k][0], lo[k][1], lo[k][2], lo[k][3], hi[k][0], hi[k][1], hi[k][2], hi[k][3]}
        o[d0] = __builtin_amdgcn_mfma_f32_32x32x16_bf16(pa0, PK(0), o[d0], 0, 0, 0);
        o[d0] = __builtin_amdgcn_mfma_f32_32x32x16_bf16(pa1, PK(1), o[d0], 0, 0, 0);
        o[d0] = __builtin_amdgcn_mfma_f32_32x32x16_bf16(pa2, PK(2), o[d0], 0, 0, 0);
        o[d0] = __builtin_amdgcn_mfma_f32_32x32x16_bf16(pa3, PK(3), o[d0], 0, 0, 0);
#undef PK
    }
}
constexpr int NKS = 4, NVS = 3;
constexpr int P_K = 0, P_V = NKS * KSLOT, P_WS = P_V + NVS * VSLOT, P_OST = P_WS + NWAVES * 64 * 4, P_END = P_OST + NWAVES * 4096;
static_assert(P_END <= RING_BYTES, "attention LDS");
typedef __attribute__((address_space(3))) const char* lds_cptr;
typedef short v4i16_t __attribute__((ext_vector_type(4)));
__device__ __forceinline__ float max3f(float a, float b, float c) { float r; asm("v_max3_f32 %0, %1, %2, %3" : "=v"(r) : "v"(a), "v"(b), "v"(c)); return r; }
__device__ __forceinline__ float max2f(float a, float b) { float r; asm("v_max_f32_e32 %0, %1, %2" : "=v"(r) : "v"(a), "v"(b)); return r; }
__device__ __forceinline__ float fadd_s(float a, float b) { float r; asm("v_add_f32_e32 %0, %1, %2" : "=v"(r) : "v"(a), "v"(b)); return r; }
__device__ __forceinline__ float fsub_s(float a, float b) { float r; asm("v_sub_f32_e32 %0, %1, %2" : "=v"(r) : "v"(a), "v"(b)); return r; }
#define WAIT_BAR(N) asm volatile("s_waitcnt vmcnt(" #N ") lgkmcnt(0)\n\ts_barrier" ::: "memory")
#define WB3() do { if (lowh) { WAIT_BAR(3); } else { WAIT_BAR(2); } } while (0)
__device__ __forceinline__ bf16x8 kld(lds_cptr p) { return *(const __attribute__((address_space(3))) bf16x8*)p; }
__device__ __forceinline__ void kload2(bf16x8* kf, lds_cptr kp, int j) { kf[2 * j] = kld(kp + j * 2048); kf[2 * j + 1] = kld(kp + j * 2048 + 512); }
__device__ __forceinline__ s16x4 vtr(lds_cptr p) { return __builtin_bit_cast(s16x4, __builtin_amdgcn_ds_read_tr16_b64_v4i16((__attribute__((address_space(3))) v4i16_t*)p)); }
__device__ __forceinline__ float rowmax(const f32x16& p0, const f32x16& p1) {
    float a = max3f(p0[0], p0[1], p1[0]), b = max3f(p0[2], p0[3], p1[1]); a = max3f(a, p1[2], p1[3]);
#pragma unroll
    for (int r = 4; r < 16; r += 4) { a = max3f(a, p0[r], p0[r + 1]); b = max3f(b, p0[r + 2], p0[r + 3]); a = max3f(a, p1[r], p1[r + 1]); b = max3f(b, p1[r + 2], p1[r + 3]); }
    const float m = max2f(a, b);
    auto rr = __builtin_amdgcn_permlane32_swap(__float_as_uint(m), __float_as_uint(m), false, false);
    return max2f(__uint_as_float(rr[0]), __uint_as_float(rr[1]));
}
__device__ __forceinline__ void qkt0(f32x16& p0, f32x16& p1, const char* Kslot, const bf16x8* qr, const f32x16& negm, int r32, int hi) {
    const char* kb = Kslot + hi * 1024 + r32 * 16;
#pragma unroll
    for (int d0 = 0; d0 < 6; ++d0) {
        const bf16x8 b0 = *reinterpret_cast<const bf16x8*>(kb + d0 * 2048);
        const bf16x8 b1 = *reinterpret_cast<const bf16x8*>(kb + d0 * 2048 + 512);
        if (d0 == 0) { p0 = __builtin_amdgcn_mfma_f32_32x32x16_bf16(b0, qr[0], negm, 0, 0, 0); p1 = __builtin_amdgcn_mfma_f32_32x32x16_bf16(b1, qr[0], negm, 0, 0, 0); }
        else { p0 = __builtin_amdgcn_mfma_f32_32x32x16_bf16(b0, qr[d0], p0, 0, 0, 0); p1 = __builtin_amdgcn_mfma_f32_32x32x16_bf16(b1, qr[d0], p1, 0, 0, 0); } }
}
template <int THRL> __device__ __forceinline__ void attn_unit(int b, int h, int qb, const bf16_t* Q, const bf16_t* __restrict__ KN, const bf16_t* __restrict__ KPE, const bf16_t* __restrict__ V, bf16_t* O, char* shm) {
    const int tid = opq(threadIdx.x), lane = tid & 63, r32 = lane & 31, hi = lane >> 5; const int wid = __builtin_amdgcn_readfirstlane(tid >> 6);
    const long rowbase = (long)b * SEQ; const int q0 = qb * 256;
    const bf16_t* Qw = Q + (rowbase + q0 + wid * 32) * QW + h * DQK;
    const unsigned lds0 = (unsigned)(uintptr_t)shm;
    float* wsf = (float*)(shm + P_WS) + wid * 64;
    const bf16_t* ksrc = KN + (rowbase + lane) * 512 + h * 64 + wid * 8;
    const bf16_t* psrc = KPE + (rowbase + lane) * 32 + (wid & 3) * 8;
    const bf16_t* vsrc = V + (rowbase + 16 * (wid & 3) + (lane >> 2)) * 512 + h * 64 + (wid >> 2) * 32 + (lane & 3) * 8;
    const unsigned kdst = lds0 + P_K + wid * 1024, pdst = lds0 + P_K + (8 + (wid & 3)) * 1024, vdst = lds0 + P_V + wid * 1024;
#define DMA_K(t, slot) do { glds16(ksrc + (long)(t) * 64 * 512, (unsigned)__builtin_amdgcn_readfirstlane(kdst + (slot))); if (lowh) glds16(psrc + (long)(t) * 64 * 32, (unsigned)__builtin_amdgcn_readfirstlane(pdst + (slot))); } while (0)
#define DMA_V(t, slot) glds16(vsrc + (long)(t) * 64 * 512, (unsigned)__builtin_amdgcn_readfirstlane(vdst + (slot)))
    const int vb0 = (int)(lds0 + P_V) + ((lane >> 4) & 1) * 32 + (lane & 3) * 8 + (4 * hi + ((lane & 15) >> 2)) * 64;
    const bool lowh = wid < 4;
    const char* Kbase = shm + P_K; bf16x8 kf[8];
    const lds_cptr shm3 = (lds_cptr)shm; const lds_cptr kp0 = shm3 + P_K + hi * 1024 + r32 * 16; const lds_cptr vp0 = shm3 + P_V + ((lane >> 4) & 1) * 32 + (lane & 3) * 8 + (4 * hi + ((lane & 15) >> 2)) * 64;
    const int NT = (q0 + 256) / 64;
    DMA_K(0, 0); DMA_V(0, 0); DMA_K(1, KSLOT);
    bf16x8 qr[6];
#pragma unroll
    for (int d0 = 0; d0 < 6; ++d0) qr[d0] = *reinterpret_cast<const bf16x8*>(&Qw[(long)r32 * QW + d0 * 16 + hi * 8]);
    float mhat = 0.f, l_reg = 0.f; f32x16 o[2], negm;
#pragma unroll
    for (int r = 0; r < 16; ++r) { float z0, z1, z2; asm volatile("v_mov_b32 %0, 0\n\tv_mov_b32 %1, 0\n\tv_mov_b32 %2, 0" : "=v"(z0), "=v"(z1), "=v"(z2)); o[0][r] = z0; o[1][r] = z1; negm[r] = z2; }
    const int qrel = wid * 32 + r32;
#define CMASK(P0, P1, t) do { int jb_ = (t) - (NT - 4); if (jb_ >= 0) cmask(P0, P1, jb_, qrel, hi); } while (0)
    bool resc = false;
#define START(P0, P1) do { const float rm = rowmax(P0, P1); resc = false; \
    { const float dl = rm; mhat = fadd_s(mhat, dl); \
      _Pragma("unroll") for (int r = 0; r < 16; ++r) { P0[r] = fsub_s(P0[r], dl); P1[r] = fsub_s(P1[r], dl); } \
      _Pragma("unroll") for (int r = 0; r < 16; ++r) negm[r] = -mhat; asm volatile("" : "+v"(negm)); } \
    _Pragma("unroll") for (int r = 0; r < 16; ++r) P0[r] = __builtin_amdgcn_exp2f(P0[r]); } while (0)
#define RESC() do { if (resc) { asm volatile("s_waitcnt lgkmcnt(0)" ::: "memory"); \
      _Pragma("unroll") for (int d_ = 0; d_ < 2; ++d_) _Pragma("unroll") for (int r = 0; r < 16; ++r) o[d_][r] *= wsf[crow(r, hi)]; } } while (0)
    f32x16 pA0, pA1, pB0, pB1;
    int ks_m1 = 3 * KSLOT, ks_cur = 0, ks_next = KSLOT;
    int vs_prev = 0, vs_cur = 0, vs_next = VSLOT;
#define ROT() do { ks_m1 = ks_cur; ks_cur = ks_next; ks_next = (ks_next == (NKS - 1) * KSLOT) ? 0 : ks_next + KSLOT; \
                   vs_prev = vs_cur; vs_cur = vs_next; vs_next = (vs_next == (NVS - 1) * VSLOT) ? 0 : vs_next + VSLOT; } while (0)
    DMA_K(2, 2 * KSLOT);
    if (lowh) { WAIT_BAR(5); } else { WAIT_BAR(3); }
    qkt0(pA0, pA1, Kbase, qr, negm, r32, hi); asm volatile("s_nop 15\n\ts_nop 7" : "+v"(pA0), "+v"(pA1)); CMASK(pA0, pA1, 0);
    START(pA0, pA1);
    _Pragma("unroll") for (int r = 0; r < 16; ++r) pA1[r] = __builtin_amdgcn_exp2f(pA1[r]);
    WAIT_BAR(0);
    DMA_K(3, 3 * KSLOT); DMA_V(1, VSLOT);
    ROT();
    kload2(kf, kp0 + ks_cur, 0); kload2(kf, kp0 + ks_cur, 1); kload2(kf, kp0 + ks_cur, 2); kload2(kf, kp0 + ks_cur, 3);
    WB3();
    s16x4 vlo[8], vhi[8]; u32x4 pw0, pw1, pw2, pw3;
#define PKW(P, B) pk2(P[B], P[B + 1])
#define PAF(k) __builtin_bit_cast(bf16x8, pw##k)
#define VFR(i) (bf16x8){vlo[i][0], vlo[i][1], vlo[i][2], vlo[i][3], vhi[i][0], vhi[i][1], vhi[i][2], vhi[i][3]}
#define PIN(x) asm volatile("" : "+v"(x))
#define MX3(a, b, c) __builtin_fmaxf(__builtin_fmaxf((a), (b)), (c))
#define MF_(a, b, c) __builtin_amdgcn_mfma_f32_32x32x16_bf16(a, b, c, 0, 0, 0)
#define GAPA3(MF, A0, A1, A2, W0, W1, PW) do { MF; sacc += A0; sacc += A1; sacc += A2; PIN(sacc); W0; W1; PIN(PW); SBAR(); } while (0)
#define GAPA2(MF, A0, A1, W0, W1, PW) do { MF; sacc += A0; sacc += A1; PIN(sacc); W0; W1; PIN(PW); SBAR(); } while (0)
#define GAPA2N(MF, A0, A1) do { MF; sacc += A0; sacc += A1; PIN(sacc); SBAR(); } while (0)
#define EX(v) __builtin_amdgcn_exp2f(v)
#define GAPB(MF, X, B) do { MF; X[B] = EX(X[B]); X[B + 1] = EX(X[B + 1]); X[B + 2] = EX(X[B + 2]); X[B + 3] = EX(X[B + 3]); PIN(X); SBAR(); } while (0)
#define VRD(i) do { vlo[i] = vtr(vp_ + (((i) >> 2) * 4096 + ((i) & 3) * 1024)); vhi[i] = vtr(vp_ + (((i) >> 2) * 4096 + ((i) & 3) * 1024 + 512)); } while (0)
#define KRD(G, j) do { if (G) { kload2(kf, kp0 + ks_next, j); SBAR(); } } while (0)
#define STEP(C0, C1, P0, P1, t, GK, GV, GL) do { SBAR(); \
    const lds_cptr vp_ = vp0 + vs_prev; const lds_cptr kq_ = kp0 + ks_cur; bf16x8 kl0, kl1, kl2, kl3; \
    float sacc = (P0[0] + P0[1]); \
    kl0 = kld(kq_ + 8192); SBAR();        GAPA3(C0 = MF_(kf[0], qr[0], negm), P0[2], P0[3], P0[4],    pw0[0] = PKW(P0, 0),  pw0[1] = PKW(P0, 2),  pw0); \
    kl1 = kld(kq_ + 8192 + 512); SBAR();  GAPA3(C1 = MF_(kf[1], qr[0], negm), P0[5], P0[6], P0[7],    pw0[2] = PKW(P0, 4),  pw0[3] = PKW(P0, 6),  pw0); \
    kl2 = kld(kq_ + 10240); SBAR();       GAPA3(C0 = MF_(kf[2], qr[1], C0),   P0[8], P0[9], P0[10],   pw1[0] = PKW(P0, 8),  pw1[1] = PKW(P0, 10), pw1); \
    kl3 = kld(kq_ + 10240 + 512); SBAR(); GAPA3(C1 = MF_(kf[3], qr[1], C1),   P0[11], P0[12], P0[13], pw1[2] = PKW(P0, 12), pw1[3] = PKW(P0, 14), pw1); \
    VRD(0); SBAR(); GAPA3(C0 = MF_(kf[4], qr[2], C0), P0[14], P0[15], P1[0], pw2[0] = PKW(P1, 0),  pw2[1] = PKW(P1, 2),  pw2); \
    VRD(4); SBAR(); GAPA3(C1 = MF_(kf[5], qr[2], C1), P1[1], P1[2], P1[3],   pw2[2] = PKW(P1, 4),  pw2[3] = PKW(P1, 6),  pw2); \
    VRD(1); SBAR(); GAPA2(C0 = MF_(kf[6], qr[3], C0), P1[4], P1[5],          pw3[0] = PKW(P1, 8),  pw3[1] = PKW(P1, 10), pw3); \
    VRD(5); SBAR(); GAPA2(C1 = MF_(kf[7], qr[3], C1), P1[6], P1[7],          pw3[2] = PKW(P1, 12), pw3[3] = PKW(P1, 14), pw3); \
    VRD(2); SBAR(); GAPA2N(C0 = MF_(kl0, qr[4], C0), P1[8], P1[9]); \
    VRD(6); SBAR(); GAPA2N(C1 = MF_(kl1, qr[4], C1), P1[10], P1[11]); \
    VRD(3); SBAR(); GAPA2N(C0 = MF_(kl2, qr[5], C0), P1[12], P1[13]); \
    VRD(7); SBAR(); GAPA2N(C1 = MF_(kl3, qr[5], C1), P1[14], P1[15]); \
    l_reg += sacc; \
    if (GK) { DMA_K((t) + 3, ks_m1); } if (GV) { DMA_V((t) + 1, vs_next); } \
    CMASK(C0, C1, t); \
    { float a = MX3(C0[0], C0[1], C1[0]), b = MX3(C0[2], C0[3], C1[1]); a = MX3(a, C1[2], C1[3]); \
      _Pragma("unroll") for (int r = 4; r < 16; r += 4) { a = MX3(a, C0[r], C0[r + 1]); b = MX3(b, C0[r + 2], C0[r + 3]); a = MX3(a, C1[r], C1[r + 1]); b = MX3(b, C1[r + 2], C1[r + 3]); } \
      float rm = __builtin_fmaxf(a, b); { auto rr = __builtin_amdgcn_permlane32_swap(__float_as_uint(rm), __float_as_uint(rm), false, false); rm = __builtin_fmaxf(__uint_as_float(rr[0]), __uint_as_float(rr[1])); } \
      resc = false; \
      if (__builtin_expect(__any(rm > (float)THRL), 0)) { const float dl = __builtin_fmaxf(rm, 0.f); mhat += dl; \
        _Pragma("unroll") for (int r = 0; r < 16; ++r) { C0[r] -= dl; C1[r] -= dl; } \
        _Pragma("unroll") for (int r = 0; r < 16; ++r) negm[r] = -mhat; asm volatile("" : "+v"(negm)); \
        const float f = __builtin_amdgcn_exp2f(-dl); l_reg *= f; if (hi == 0) wsf[r32] = f; resc = true; } } \
    SBAR(); \
    GAPB(o[0] = MF_(PAF(0), VFR(0), o[0]), C0, 0); \
    GAPB(o[1] = MF_(PAF(0), VFR(4), o[1]), C0, 4); \
    KRD(GL, 0); GAPB(o[0] = MF_(PAF(1), VFR(1), o[0]), C0, 8); \
    KRD(GL, 1); GAPB(o[1] = MF_(PAF(1), VFR(5), o[1]), C0, 12); \
    KRD(GL, 2); GAPB(o[0] = MF_(PAF(2), VFR(2), o[0]), C1, 0); \
    KRD(GL, 3); GAPB(o[1] = MF_(PAF(2), VFR(6), o[1]), C1, 4); \
    GAPB(o[0] = MF_(PAF(3), VFR(3), o[0]), C1, 8); \
    GAPB(o[1] = MF_(PAF(3), VFR(7), o[1]), C1, 12); \
    } while (0)
    int t = 1;
#undef CMASK
#define CMASK(P0, P1, t) do { } while (0)
    for (; t + 5 < NT; t += 2) {
        STEP(pB0, pB1, pA0, pA1, t, true, true, true);       WB3(); RESC(); ROT();
        STEP(pA0, pA1, pB0, pB1, t + 1, true, true, true);   WB3(); RESC(); ROT();
    }
#undef CMASK
#define CMASK(P0, P1, t) do { int jb_ = (t) - (NT - 4); if (jb_ >= 0) cmask(P0, P1, jb_, qrel, hi); } while (0)
#define ENDW(tt) do { if ((tt) + 3 < NT) { WB3(); } else if ((tt) + 2 < NT) { WAIT_BAR(1); } else { WAIT_BAR(0); } } while (0)
    for (; t + 1 < NT; t += 2) {
        STEP(pB0, pB1, pA0, pA1, t, (t + 3 < NT), (t + 1 < NT), (t + 1 < NT));       ENDW(t);     RESC(); ROT();
        STEP(pA0, pA1, pB0, pB1, t + 1, (t + 4 < NT), (t + 2 < NT), (t + 2 < NT));   ENDW(t + 1); RESC(); ROT();
    }
    STEP(pB0, pB1, pA0, pA1, NT - 1, false, false, false); RESC();
    { float sacc = pB0[0] + pB0[1]; _Pragma("unroll") for (int r = 2; r < 16; ++r) sacc += pB0[r]; _Pragma("unroll") for (int r = 0; r < 16; ++r) sacc += pB1[r]; l_reg += sacc;
      pw0 = (u32x4){PKW(pB0, 0), PKW(pB0, 2), PKW(pB0, 4), PKW(pB0, 6)}; pw1 = (u32x4){PKW(pB0, 8), PKW(pB0, 10), PKW(pB0, 12), PKW(pB0, 14)};
      pw2 = (u32x4){PKW(pB1, 0), PKW(pB1, 2), PKW(pB1, 4), PKW(pB1, 6)}; pw3 = (u32x4){PKW(pB1, 8), PKW(pB1, 10), PKW(pB1, 12), PKW(pB1, 14)};
      SBAR(); pv(o, vb0 + vs_cur, PAF(0), PAF(1), PAF(2), PAF(3)); }
#undef PKW
#undef PAF
#undef VFR
#undef PIN
#undef MX3
#undef MF_
#undef GAPA3
#undef GAPA2
#undef GAPA2N
#undef GAPB
#undef EX
#undef VRD
#undef KRD
#undef STEP
#undef ENDW
    { auto rr = __builtin_amdgcn_permlane32_swap(__float_as_uint(l_reg), __float_as_uint(l_reg), false, false); l_reg = __uint_as_float(rr[0]) + __uint_as_float(rr[1]); }
    if (hi == 0) wsf[32 + r32] = l_reg; asm volatile("s_waitcnt lgkmcnt(0)" ::: "memory");
    float rli[16];
#pragma unroll
    for (int r = 0; r < 16; ++r) rli[r] = __builtin_amdgcn_rcpf(wsf[32 + crow(r, hi)]);
    bf16_t* Ow = O + (rowbase + q0 + wid * 32) * 1024 + h * 64;
    { bf16_t* stg = (bf16_t*)(shm + P_OST) + wid * 2048;
#pragma unroll
        for (int r = 0; r < 16; ++r) { const int orow = crow(r, hi);
#pragma unroll
            for (int d0 = 0; d0 < 2; ++d0) stg[orow * 64 + d0 * 32 + r32] = f2bf(o[d0][r] * rli[r]); }
        asm volatile("s_waitcnt lgkmcnt(0)" ::: "memory");
#pragma unroll
        for (int i = 0; i < 4; ++i) { const int row = i * 8 + (lane >> 3), ch = lane & 7; const u32x4 v = *(const u32x4*)(stg + row * 64 + ch * 8); *(u32x4*)(Ow + (long)row * 1024 + ch * 8) = v; } }
    asm volatile("s_waitcnt lgkmcnt(0)\n\ts_barrier" ::: "memory");
#undef DMA_K
#undef DMA_V
#undef CMASK
#undef START
#undef RESC
#undef ROT
#undef WAIT_BAR
#undef WB3
}
#undef SBAR
}

typedef GAS unsigned gu32;
#define RLX_AGENT __ATOMIC_RELAXED, __HIP_MEMORY_SCOPE_AGENT
#define XB_TMO      128
#define XB_XCNT(j)  (256  + 64 * (j))
#define XB_XSUB(j)  (1280 + 64 * (j))
#define XB_XGEN(j)  (2304 + 64 * (j))
#define XB_TOP      3328
#define XB_TOPGEN   3392
#define XCD_BAR_WORDS 3456
#define XB_SPIN_CAP (1u << 22)
__device__ __forceinline__ unsigned xb_ld(unsigned* p)              { return __hip_atomic_load(p, __ATOMIC_RELAXED, __HIP_MEMORY_SCOPE_AGENT); }
__device__ __forceinline__ unsigned xb_add(unsigned* p, unsigned v) { return __hip_atomic_fetch_add(p, v, __ATOMIC_RELAXED, __HIP_MEMORY_SCOPE_AGENT); }
__device__ __forceinline__ unsigned xb_xcc_id() { return (unsigned)__builtin_amdgcn_s_getreg((3 << 11) | 20) & 0xFu; }
#define XB_SPIN(cond, bar) do { unsigned _sp = 0; while (cond) { __builtin_amdgcn_s_sleep(1); \
    if ((++_sp & 255u) == 0u) { if (xb_ld(&(bar)[XB_TMO])) break; if (_sp > XB_SPIN_CAP) { atomicAdd(&(bar)[XB_TMO], 1u); break; } } } } while (0)
struct XcdBarrier { unsigned* bar; unsigned x; volatile LAS unsigned* st; };
__device__ __forceinline__ XcdBarrier xcd_barrier_post(unsigned* bar, volatile LAS unsigned* st) {
    XcdBarrier b; b.bar = bar; b.x = xb_xcc_id(); b.st = st;
    if (threadIdx.x == 0) (void)xb_add(&bar[XB_XCNT(b.x)], 1u);
    return b;
}
__device__ __forceinline__ void xcd_barrier_complete(unsigned* bar, unsigned x, unsigned& nloc, unsigned& nx) {
    const unsigned G = gridDim.x * gridDim.y * gridDim.z;
    unsigned sum, cnt, mine, sp = 0u;
    for (;;) {
        sum = 0u; cnt = 0u; mine = 0u;
#pragma unroll
        for (unsigned j = 0; j < 16; ++j) { const unsigned c = xb_ld(&bar[XB_XCNT(j)]); sum += c; cnt += (c > 0u) ? 1u : 0u; mine = (j == x) ? c : mine; }
        if (sum == G) break;
        __builtin_amdgcn_s_sleep(1);
        if ((++sp & 255u) == 0u) { if (xb_ld(&bar[XB_TMO])) break; if (sp > XB_SPIN_CAP) { atomicAdd(&bar[XB_TMO], 1u); break; } }
    }
    nloc = mine > 0u ? mine : 1u; nx = cnt > 0u ? cnt : 1u;
}
__device__ __forceinline__ void xcd_barrier(const XcdBarrier& b) {
    asm volatile("s_waitcnt vmcnt(0)" ::: "memory");
    __syncthreads();
    if (threadIdx.x == 0) {
        unsigned* bar = b.bar;
        __builtin_amdgcn_s_waitcnt(0);
        unsigned nloc = b.st[0], nx = b.st[1];
        if (nloc == 0u) { xcd_barrier_complete(bar, b.x, nloc, nx); b.st[0] = nloc; b.st[1] = nx; }
        const unsigned old = xb_add(&bar[XB_XSUB(b.x)], 1u);
        const unsigned gen = old / nloc;
        if (old + 1u == (gen + 1u) * nloc) {
            __builtin_amdgcn_fence(__ATOMIC_RELEASE, "agent");
            asm volatile("s_waitcnt vmcnt(0)" ::: "memory");
            const unsigned og = xb_add(&bar[XB_TOP], 1u);
            const unsigned tg = og / nx;
            if (og + 1u == (tg + 1u) * nx) xb_add(&bar[XB_TOPGEN], 1u);
            else XB_SPIN(xb_ld(&bar[XB_TOPGEN]) == tg, bar);
            __builtin_amdgcn_fence(__ATOMIC_ACQUIRE, "agent");
            xb_add(&bar[XB_XGEN(b.x)], 1u);
            asm volatile("s_waitcnt vmcnt(0)" ::: "memory");
        } else {
            XB_SPIN(xb_ld(&bar[XB_XGEN(b.x)]) == gen, bar);
            __builtin_amdgcn_fence(__ATOMIC_ACQUIRE, "agent");
            asm volatile("s_waitcnt vmcnt(0)" ::: "memory");
        }
    }
    __syncthreads();
}

struct Args { const void* in[27]; float* out; unsigned char* ws; int ph_lo, ph_hi; };
enum { I_X = 0, I_C, I_POS, I_WADA, I_BADA, I_N1G, I_WIN, I_QNG, I_WUQ, I_KVNG, I_WUKV, I_VNG, I_VNB, I_WS, I_BS, I_WBRM, I_WBRS, I_WOUT, I_N2G, I_WRG, I_BRG, I_WRE, I_BRE, I_W1, I_W3, I_W2, I_FG };
constexpr int NPHASE = 12;

__device__ __forceinline__ int ropeidx(int p) { return 4 * (p >> 3) + (p & 3) + 16 * ((p >> 2) & 1); }

__device__ __forceinline__ void tr_item(const float* W, int N, int k0, int n0, bf16_t* WT, int ldk, int drow0, const float* gk, float mul, bool rp, LAS float* scr, int lane, int dcol0 = 0) {
#pragma unroll 8
    for (int i = 0; i < 32; ++i) { const int kk = 2 * i + (lane >> 5); float v = __builtin_nontemporal_load(W + (size_t)(k0 + kk) * N + n0 + (lane & 31)); if (gk) v *= gk[k0 + kk]; scr[kk * 33 + (lane & 31)] = v * mul; }
    LDS_WAIT(); asm volatile("" ::: "memory");
    const int c = lane & 7;
#pragma unroll
    for (int j = 0; j < 4; ++j) { const int p = (lane >> 3) + 8 * j; const int n = rp ? ropeidx(p) : p; const LAS float* s = scr + (8 * c) * 33 + n;
        u32x4 o; o.x = pk2(s[0 * 33], s[1 * 33]); o.y = pk2(s[2 * 33], s[3 * 33]); o.z = pk2(s[4 * 33], s[5 * 33]); o.w = pk2(s[6 * 33], s[7 * 33]);
        *(u32x4*)(WT + (size_t)(drow0 + p) * ldk + dcol0 + k0 + 8 * c) = o; }
    LDS_WAIT(); asm volatile("" ::: "memory");
}
__device__ __forceinline__ int win_drow(int n) {
    if (n < 416) return n; if (n < 1440) return n + 96;
    if (n < 2464) { const int c = n - 1440; return 1536 + 256 * (c >> 7) + (c & 127); }
    const int c = n - 2464; return 1536 + 256 * (c >> 7) + 128 + (c & 127);
}

__device__ __forceinline__ void wg_tile(const float* W, int N, int k0, int n0, bf16_t* WT, int ldk, int dbase, int dcol0, bool il, LAS float* tile, int wave, int lane) {
    f32x4 v[8];
#pragma unroll
    for (int i = 0; i < 8; ++i) v[i] = __builtin_nontemporal_load((const f32x4*)(W + (size_t)(k0 + 8 * wave + i) * N + n0 + 4 * lane));
#pragma unroll
    for (int i = 0; i < 8; ++i) { LAS float* tp_ = tile + (8 * wave + i) * 257 + 4 * lane; tp_[0] = v[i][0]; tp_[1] = v[i][1]; tp_[2] = v[i][2]; tp_[3] = v[i][3]; }
    __syncthreads();
    const int c = lane & 7;
#pragma unroll
    for (int j = 0; j < 4; ++j) { const int nl = 32 * wave + (lane >> 3) + 8 * j, n = n0 + nl; const LAS float* sp_ = tile + (8 * c) * 257 + nl;
        u32x4 o; o.x = pk2(sp_[0 * 257], sp_[1 * 257]); o.y = pk2(sp_[2 * 257], sp_[3 * 257]); o.z = pk2(sp_[4 * 257], sp_[5 * 257]); o.w = pk2(sp_[6 * 257], sp_[7 * 257]);
        const int drow = il ? dbase + 256 * (n >> 7) + (n & 127) : dbase + n;
        *(u32x4*)(WT + (size_t)drow * ldk + dcol0 + k0 + 8 * c) = o; }
    __syncthreads();
}

typedef const char __attribute__((address_space(4)))* kargp_t;
__device__ __forceinline__ kargp_t launder_k(kargp_t p) { asm volatile("" : "+s"(p)); return p; }
#define KIN(k) (*(const void* const __attribute__((address_space(4)))*)(launder_k(kbase) + 8 * (k)))
__global__ void __launch_bounds__(NWAVES * 64, 2) fwd_kernel(Args args) {
    const kargp_t kbase = (kargp_t)__builtin_amdgcn_kernarg_segment_ptr();
    extern __shared__ __attribute__((aligned(16))) unsigned char lds[];
    LAS unsigned char* const L = (LAS unsigned char*)lds;
    volatile LAS unsigned* const MISC = (volatile LAS unsigned*)(L + MISC_OFF);
    const int tid0 = threadIdx.x, wave = __builtin_amdgcn_readfirstlane(tid0 >> 6);
    const int G = gridDim.x; const int bx = blockIdx.x; const int vcu = (G % 8 == 0) ? (bx % 8) * (G / 8) + bx / 8 : bx;
    const int gw = vcu * NWAVES + wave, NGW = G * NWAVES;
    unsigned char* const ws = args.ws;
    unsigned* const ctl = (unsigned*)(ws + WS_CTL);
    float* const mod = (float*)(ws + WS_MOD);
    float* const ssqq = (float*)(ws + WS_SSQQ); float* const ssqkv = (float*)(ws + WS_SSQKV);
    unsigned* const ecnt = ctl + CW_CNT;
    const float* const x = (const float*)KIN(I_X);
    float* const out = args.out;
    for (int u = tid0; u < 64; u += NWAVES * 64) MISC[u] = 0u;
    __syncthreads();
    const int lo = args.ph_lo, hi = args.ph_hi;
    XcdBarrier bar; bar.bar = ctl + CW_BAR; bar.x = 0; bar.st = nullptr;
    if (hi - lo > 1) bar = xcd_barrier_post(ctl + CW_BAR, MISC + 8);
#ifndef PH_MASK
#define PH_MASK 0xFFF
#endif
#define IN(k) (((PH_MASK >> (k)) & 1) && lo <= (k) && (k) < hi)
#define SEAM(k) do { if (IN(k) && IN((k) + 1)) xcd_barrier(bar); } while (0)

    if (IN(0)) {
        const int tid = opq(tid0), lane = tid & 63; (void)tid;
        LAS float* scr = (LAS float*)(L + wave * 16384);
        bf16_t* const WIN = (bf16_t*)(ws + WS_WIN); bf16_t* const WUP = (bf16_t*)(ws + WS_WUP); bf16_t* const WBR = (bf16_t*)(ws + WS_WBR);
        bf16_t* const WOUT = (bf16_t*)(ws + WS_WOUT); bf16_t* const W13 = (bf16_t*)(ws + WS_W13); bf16_t* const W2 = (bf16_t*)(ws + WS_W2);
        { const float* wada = (const float*)KIN(I_WADA); const float* badA = (const float*)KIN(I_BADA); const float* cvec = (const float*)KIN(I_C);
            LAS float* part = (LAS float*)(L + 12288);
            for (int cg = vcu; cg < 96; cg += G) { const int col = 64 * cg + lane; float s0 = 0.f, s1 = 0.f;
#pragma unroll
                for (int kk = 0; kk < 2; ++kk) { const int kb = 128 * wave + 64 * kk;
                    const float c0 = cvec[kb + lane], c1 = cvec[DM + kb + lane]; const float a0 = c0 * sigmoidf_(c0), a1 = c1 * sigmoidf_(c1);
#pragma unroll 16
                    for (int k = 0; k < 64; ++k) { const float w = __builtin_nontemporal_load(wada + (size_t)(kb + k) * 6144 + col); s0 += __uint_as_float(__builtin_amdgcn_readlane(__float_as_uint(a0), k)) * w; s1 += __uint_as_float(__builtin_amdgcn_readlane(__float_as_uint(a1), k)) * w; } }
                part[(wave * 2 + 0) * 64 + lane] = s0; part[(wave * 2 + 1) * 64 + lane] = s1;
                __syncthreads();
                if (tid < 128) { const int b = tid >> 6, l = tid & 63; float a = badA[64 * cg + l];
#pragma unroll
                    for (int w = 0; w < 8; ++w) a += part[(w * 2 + b) * 64 + l];
                    mod[b * 6144 + 64 * cg + l] = a; }
                __syncthreads();
                if (tid == 0) { __builtin_amdgcn_fence(__ATOMIC_RELEASE, "agent"); (void)xb_add(ctl + CW_MODRDY, 1u); } } }
        { constexpr int TOUT = 16 * 4, TBR = 8 * 4, NTILE = TOUT + 2 * TBR;
            LAS float* tile = (LAS float*)L;
            for (int it = G - 1 - vcu; it < NTILE; it += G) {
                int r = it;
                if (r < TOUT) wg_tile((const float*)KIN(I_WOUT), DM, 64 * (r >> 2), 256 * (r & 3), WOUT, DM, 0, 0, false, tile, wave, lane);
                else { r -= TOUT; const int br = r / TBR; r %= TBR; wg_tile((const float*)KIN(br ? I_WBRS : I_WBRM), DM, 64 * (r >> 2), 256 * (r & 3), WBR, DM, 0, br * 512, false, tile, wave, lane); }
            }
        }
        constexpr int I_IN = 16 * 109, I_UQ = 4 * 24, I_UKV = 2 * 32;
        constexpr int NIT = I_IN + I_UQ + I_UKV;
        for (int it = gw; it < NIT; it += NGW) {
            int r = it;
            if (r < I_IN) { const int kb = r / 109, nb = r % 109; tr_item((const float*)KIN(I_WIN), INW, 64 * kb, 32 * nb, WIN, DM, win_drow(32 * nb), nullptr, 1.f, false, scr, lane); continue; } r -= I_IN;
            if (r < I_UQ) { const int kb = r / 24, nb = r % 24; tr_item((const float*)KIN(I_WUQ), QW, 64 * kb, 32 * nb, WUP, 256, 32 * nb, (const float*)KIN(I_QNG), C2, (nb % 3) == 2, scr, lane); continue; } r -= I_UQ;
            { const int kb = r / 32, nb = r % 32; tr_item((const float*)KIN(I_WUKV), 1024, 64 * kb, 32 * nb, WUP, 256, 768 + 32 * nb, (const float*)KIN(I_KVNG), 1.f, false, scr, lane); }
        }
        for (int it = gw; it < 96 * 2 + 1024 / 4; it += NGW) {
            const u32x4 z = {0u, 0u, 0u, 0u};
            if (it < 192) { const int row = 416 + it / 2, c0 = (it & 1) * 512 + lane * 8; *(u32x4*)(WIN + (size_t)row * DM + c0) = z; }
            else { const int row = 768 + (it - 192) * 4 + (lane >> 4), c0 = 128 + (lane & 15) * 8; *(u32x4*)(WUP + (size_t)row * 256 + c0) = z; }
        }
        { const int* pos = (const int*)KIN(I_POS); f32x2* cs = (f32x2*)(ws + WS_CS);
            for (int it = gw * 64 + lane; it < NTOK * 16; it += NGW * 64) { const int tok = it >> 4, i = it & 15;
                const float freq = exp2f(-(float)i * (13.287712379549449f / 16.0f)); const float ang = (float)pos[tok] * freq;
                const double rv = (double)ang * 0.15915494309189535; const float fr = (float)(rv - rint(rv));
                cs[it] = (f32x2){__builtin_amdgcn_cosf(fr), __builtin_amdgcn_sinf(fr)}; } }
        { const float* wsp = (const float*)KIN(I_WS); bf16_t* wst = (bf16_t*)(ws + WS_WSTRIL);
            for (int it = gw * 64 + lane; it < 8 * 128 * 128; it += NGW * 64) { const int t = (it >> 7) & 127, s = it & 127; wst[it] = f2bf(s <= t ? wsp[it] : 0.f); } }
    }
    if (IN(0) || IN(1)) { if (tid0 == 0) { XB_SPIN(xb_ld(ctl + CW_MODRDY) < 96u, ctl + CW_BAR); __builtin_amdgcn_fence(__ATOMIC_ACQUIRE, "agent"); } __syncthreads(); }

    if (IN(1)) {
        const int tid = opq(tid0), lane = tid & 63; (void)tid;
        bf16_t* XN = (bf16_t*)(ws + WS_XN); const float* g1 = (const float*)KIN(I_N1G);
        for (int m0 = gw; m0 < NTOK; m0 += 2 * NGW) {
            f32x4 v[2][4];
#pragma unroll
            for (int q = 0; q < 2; ++q) { const f32x4* xr = (const f32x4*)(x + (size_t)(m0 + q * NGW) * DM) + lane;
#pragma unroll
                for (int j = 0; j < 4; ++j) v[q][j] = __builtin_nontemporal_load(xr + 64 * j); }
#pragma unroll
            for (int q = 0; q < 2; ++q) { const int m = m0 + q * NGW; const float* md = mod + (m / SEQ) * 6144; float s_ = 0.f;
#pragma unroll
                for (int j = 0; j < 4; ++j) s_ += (v[q][j][0] * v[q][j][0] + v[q][j][1] * v[q][j][1]) + (v[q][j][2] * v[q][j][2] + v[q][j][3] * v[q][j][3]);
                const float rs = 1.0f / sqrtf(wave_sum(s_) * (1.f / DM) + EPS);
                u32x2* o8 = (u32x2*)(XN + (size_t)m * DM) + lane;
#pragma unroll
                for (int j = 0; j < 4; ++j) { const int col = 256 * j + 4 * lane; const f32x4 gg = *(const f32x4*)(g1 + col), sc = *(const f32x4*)(md + 1024 + col), sh = *(const f32x4*)(md + col);
                    const f32x4 h = v[q][j] * rs * gg * (sc + 1.0f) + sh; o8[64 * j] = (u32x2){pk2(h[0], h[1]), pk2(h[2], h[3])}; } } }
        { const float* g2 = (const float*)KIN(I_N2G); const float* wrg = (const float*)KIN(I_WRG); const float* wre = (const float*)KIN(I_WRE);
            const float* brg = (const float*)KIN(I_BRG); const float* bre = (const float*)KIN(I_BRE); float* BP = (float*)(ws + WS_BIASP);
            bf16_t* WPH = (bf16_t*)(ws + WS_WPH); bf16_t* WPL = (bf16_t*)(ws + WS_WPL);
            for (int it = gw * 64 + lane; it < 2 * 64 * 1024; it += NGW * 64) { const int b = it >> 16, n = (it >> 10) & 63, k = it & 1023;
                float w = 0.f; if (n < 36) w = g2[k] * (1.0f + mod[b * 6144 + 4096 + k]) * ((n < 4) ? wrg[k * 4 + n] : wre[k * 32 + n - 4]);
                const bf16_t h = f2bf(w); WPH[it] = h; WPL[it] = f2bf(w - bf2f(h)); }
            for (int it = gw; it < 72; it += NGW) { const int b = it / 36, n = it % 36; float a = 0.f;
                for (int k = lane; k < 1024; k += 64) a += mod[b * 6144 + 3072 + k] * ((n < 4) ? wrg[k * 4 + n] : wre[k * 32 + n - 4]);
                a = wave_sum(a); if (lane == 0) BP[it] = a + ((n < 4) ? brg[n] : bre[n - 4]); } }
    }
    SEAM(1);

    if (IN(2)) {
        pg8::Gemm g{(const bf16_t*)(ws + WS_XN), (const bf16_t*)(ws + WS_WIN), DM, DM};
        OrderGrid S; S.gm.init(NTOK / 256, NPROJ / 256); S.G = G; S.c = bx; S.split_pn = 1000; S.acol_hi = 0;
        EpiProj E{(bf16_t*)(ws + WS_CQKV), (bf16_t*)(ws + WS_AS) + 512, (bf16_t*)(ws + WS_SGUV), (bf16_t*)(ws + WS_GATES), ssqq, ssqkv};
        pg8::gemm_phase<EpiProj, OrderGrid, false>(L, g, S, E, nullptr);
    }
    SEAM(2);

    if (IN(3)) {
        const int tid = opq(tid0), lane = tid & 63; (void)tid;
        pg8::Gemm g{(const bf16_t*)(ws + WS_CQKV), (const bf16_t*)(ws + WS_WUP), 512, 256};
        OrderGrid S; S.gm.init(NTOK / 256, 7); S.G = G; S.c = bx; S.split_pn = 3; S.acol_hi = 256;
        EpiUp E{(bf16_t*)(ws + WS_Q), (bf16_t*)(ws + WS_KN), (bf16_t*)(ws + WS_V), ssqq, ssqkv, (const f32x4*)(ws + WS_CS)};
        pg8::gemm_phase<EpiUp, OrderGrid, false>(L, g, S, E, nullptr);
        { const bf16_t* cq = (const bf16_t*)(ws + WS_CQKV); bf16_t* kpe = (bf16_t*)(ws + WS_KPE); const f32x2* cs = (const f32x2*)(ws + WS_CS);
            for (int it = gw * 64 + lane; it < NTOK * 32; it += NGW * 64) { const int tok = it >> 5, p = it & 31, i = 4 * (p >> 3) + (p & 3), n = (p >> 2) & 1;
                const float x1 = bf2f(cq[(size_t)tok * 512 + 384 + i]), x2 = bf2f(cq[(size_t)tok * 512 + 384 + 16 + i]); const f32x2 c = cs[tok * 16 + i];
                kpe[it] = f2bf(n ? x1 * c[1] + x2 * c[0] : x1 * c[0] - x2 * c[1]); } }
    }
    if (IN(3)) {
        const int tid = opq(tid0), lane = tid & 63; (void)tid;
        const bf16_t* SV = (const bf16_t*)(ws + WS_SGUV); bf16_t* SO = (bf16_t*)(ws + WS_AS) + 512;
        const bf16_t* wst = (const bf16_t*)(ws + WS_WSTRIL); const float* vng = (const float*)KIN(I_VNG); const float* vnb = (const float*)KIN(I_VNB); const float* bs = (const float*)KIN(I_BS);
        for (int ch = vcu; ch < NTOK / 128; ch += G) {
            const int tok0 = ch * 128;
#define SGU_ULOAD(U, TB0) do { const int r32_ = lane & 31, hh_ = lane >> 5; \
                _Pragma("unroll") for (int tb_ = 0; tb_ < 2; ++tb_) _Pragma("unroll") for (int cb = 0; cb < 2; ++cb) _Pragma("unroll") for (int r = 0; r < 16; ++r) \
                    U[tb_][cb][r] = SO[(size_t)(tok0 + 32 * ((TB0) + tb_) + (r & 3) + 8 * (r >> 2) + 4 * hh_) * 1024 + 64 * wave + 32 * cb + r32_]; } while (0)
            bf16_t uA[2][2][16], uB[2][2][16];
            SGU_ULOAD(uA, 0);
            float gn[8], bn[8];
#pragma unroll
            for (int i = 0; i < 8; ++i) { gn[i] = vng[lane + 64 * i]; bn[i] = vnb[lane + 64 * i]; }
            for (int rr = 0; rr < 16; ++rr) { const int sp = wave * 16 + rr; const bf16_t* vr = SV + (size_t)(tok0 + sp) * 512; float xv[8]; float s = 0.f, s2 = 0.f;
#pragma unroll
                for (int i = 0; i < 8; ++i) { xv[i] = bf2f(vr[lane + 64 * i]); s += xv[i]; }
                const float mu = wave_sum(s) * (1.f / 512.f);
#pragma unroll
                for (int i = 0; i < 8; ++i) { xv[i] -= mu; s2 += xv[i] * xv[i]; }
                const float rstd = 1.0f / sqrtf(wave_sum(s2) * (1.f / 512.f) + EPS);
#pragma unroll
                for (int i = 0; i < 8; ++i) { const int c = lane + 64 * i; *(LAS bf16_t*)(L + c * 256 + ((((sp >> 3) ^ (c & 15)) << 4) | ((sp & 7) << 1))) = f2bf(xv[i] * rstd * gn[i] + bn[i]); } }
            __syncthreads();
            { const int g = wave, r32 = lane & 31, hh = lane >> 5;
#define SGU_BLOCK(tb, U, ti) do { f32x16 acc[2]; acc[0] = f32x16{}; acc[1] = f32x16{}; \
                    _Pragma("unroll 2") for (int ks = 0; ks < 2 * (tb) + 2; ++ks) { \
                        const bf16x8 a = *(const bf16x8*)(wst + (size_t)g * 16384 + (32 * (tb) + r32) * 128 + 16 * ks + 8 * hh); \
                        _Pragma("unroll") for (int cb = 0; cb < 2; ++cb) { const int c = 64 * g + 32 * cb + r32; \
                            const bf16x8 b = *(const LAS bf16x8*)(L + c * 256 + (((2 * ks + hh) ^ (c & 15)) << 4)); \
                            acc[cb] = __builtin_amdgcn_mfma_f32_32x32x16_bf16(a, b, acc[cb], 0, 0, 0); } } \
                      \
                    _Pragma("unroll") for (int r = 0; r < 16; ++r) { const int t = 32 * (tb) + (r & 3) + 8 * (r >> 2) + 4 * hh; const float bb = bs[g * 128 + t]; \
                        _Pragma("unroll") for (int cb = 0; cb < 2; ++cb) { const size_t off = (size_t)(tok0 + t) * 1024 + 64 * g + 32 * cb + r32; SO[off] = f2bf((acc[cb][r] + bb) * bf2f(U[ti][cb][r])); } } } while (0)
                SGU_BLOCK(0, uA, 0);
                SGU_ULOAD(uB, 2);
                SGU_BLOCK(1, uA, 1);
                SGU_BLOCK(2, uB, 0);
                SGU_BLOCK(3, uB, 1);
#undef SGU_BLOCK
#undef SGU_ULOAD
            }
            __syncthreads();
        }
        if (bx >= G / 2) for (int i3 = 0; i3 < 3; ++i3) {
            if (tid0 == 0) MISC[102] = xb_add(ctl + CW_WQ, 1u);
            __syncthreads(); const unsigned tq = MISC[102];
            if (tq >= (unsigned)W13_TILES) { __syncthreads(); break; }
            { const int kind_ = (int)tq >> 10, r_ = (int)tq & 1023, e_ = r_ >> 5, q_ = r_ & 31; wg_tile((const float*)KIN(kind_ ? I_W3 : I_W1) + (size_t)e_ * DM * EFF, EFF, 64 * (q_ >> 1), 256 * (q_ & 1), (bf16_t*)(ws + WS_W13), DM, e_ * 1024 + 128 * kind_, 0, true, (LAS float*)L, wave, lane); } }
    }
    SEAM(3);

    if (IN(4)) {
        const int bh = vcu >> 4, s = vcu & 15;
        for (int i = 0; i < 4; ++i) { const int qb = (i == 0) ? s : (i == 1) ? 31 - s : (i == 2) ? 32 + s : 63 - s;
            attn::attn_unit<8>(bh >> 3, bh & 7, qb, (const bf16_t*)(ws + WS_Q), (const bf16_t*)(ws + WS_KN), (const bf16_t*)(ws + WS_KPE), (const bf16_t*)(ws + WS_V), (bf16_t*)(ws + WS_AS), (char*)lds); }
        { const int lane_ = opq(tid0) & 63;
            if (tid0 == 0) (void)xb_add(ctl + CW_ADONE, 1u);
            for (;;) {
                if (tid0 == 0) { unsigned tq_ = 0xffffffffu; if (xb_ld(ctl + CW_ADONE) + 16u < (unsigned)G) tq_ = xb_add(ctl + CW_WQ, 1u); MISC[102] = tq_; }
                __syncthreads(); const unsigned tq = MISC[102];
                if (tq >= (unsigned)W13_TILES) { __syncthreads(); break; }
                { const int kind_ = (int)tq >> 10, r_ = (int)tq & 1023, e_ = r_ >> 5, q_ = r_ & 31; wg_tile((const float*)KIN(kind_ ? I_W3 : I_W1) + (size_t)e_ * DM * EFF, EFF, 64 * (q_ >> 1), 256 * (q_ & 1), (bf16_t*)(ws + WS_W13), DM, e_ * 1024 + 128 * kind_, 0, true, (LAS float*)L, wave, lane_); } } }
    }
    SEAM(4);


    if (IN(6)) {
        pg8::Gemm g{(const bf16_t*)(ws + WS_AS), (const bf16_t*)(ws + WS_WBR), DM, DM};
        OrderGrid S; S.gm.init(NTOK / 256, 4); S.G = G; S.c = bx; S.split_pn = 1000; S.acol_hi = 0;
        EpiBranch E{(const bf16_t*)(ws + WS_GATES), (bf16_t*)(ws + WS_MERGED)};
        pg8::gemm_phase<EpiBranch, OrderGrid, false>(L, g, S, E, nullptr);
    }
    SEAM(6);

    if (IN(7)) {
        pg8::Gemm g{(const bf16_t*)(ws + WS_MERGED), (const bf16_t*)(ws + WS_WOUT), DM, DM};
        OrderGrid S; S.gm.init(NTOK / 256, 4); S.G = G; S.c = bx; S.split_pn = 1000; S.acol_hi = 0;
        EpiOut E{x, mod, (bf16_t*)(ws + WS_X1B)};
        pg8::gemm_phase<EpiOut, OrderGrid, false>(L, g, S, E, nullptr);
    }
    SEAM(7);

    if (IN(8)) {
        const int tid = opq(tid0), lane = tid & 63; (void)tid;
        bf16_t* H2 = (bf16_t*)(ws + WS_H2); const float* g2 = (const float*)KIN(I_N2G);
        const float* BP = (const float*)(ws + WS_BIASP);
        unsigned* list = (unsigned*)(ws + WS_LIST); float* lw = (float*)(ws + WS_LW); unsigned* const ecnt_ = ecnt;
        LAS float* part = (LAS float*)L;
        LAS float* rsl = (LAS float*)(L + 114688);
        const bf16_t* WPH = (const bf16_t*)(ws + WS_WPH); const bf16_t* WPL = (const bf16_t*)(ws + WS_WPL); const bf16_t* X1B = (const bf16_t*)(ws + WS_X1B);
        const int r32 = lane & 31, hh = lane >> 5;
        for (int blk = vcu; blk < NTOK / 128; blk += G) {
            const int row0 = blk * 128, b = row0 / SEQ; const int rh = wave & 1, ksl = wave >> 1;
            f32x16 acc[2][2]; float sq[2] = {0.f, 0.f};
#pragma unroll
            for (int i = 0; i < 2; ++i)
#pragma unroll
                for (int j = 0; j < 2; ++j) acc[i][j] = f32x16{};
#pragma unroll 4
            for (int ks = 0; ks < 16; ++ks) { const int k = 256 * ksl + 16 * ks + 8 * hh;
                bf16x8 bh[2], bl[2];
#pragma unroll
                for (int cb = 0; cb < 2; ++cb) { bh[cb] = *(const bf16x8*)(WPH + (size_t)(b * 64 + 32 * cb + r32) * 1024 + k); bl[cb] = *(const bf16x8*)(WPL + (size_t)(b * 64 + 32 * cb + r32) * 1024 + k); }
#pragma unroll
                for (int rb = 0; rb < 2; ++rb) { const u32x4 xw = *(const u32x4*)(X1B + (size_t)(row0 + 64 * rh + 32 * rb + r32) * DM + k);
                    const float e0 = bflo(xw.x), e1 = bfhi(xw.x), e2 = bflo(xw.y), e3 = bfhi(xw.y), e4 = bflo(xw.z), e5 = bfhi(xw.z), e6 = bflo(xw.w), e7 = bfhi(xw.w);
                    sq[rb] += (e0 * e0 + e1 * e1) + (e2 * e2 + e3 * e3) + (e4 * e4 + e5 * e5) + (e6 * e6 + e7 * e7);
                    const bf16x8 ah = __builtin_bit_cast(bf16x8, xw);
#pragma unroll
                    for (int cb = 0; cb < 2; ++cb) { acc[rb][cb] = __builtin_amdgcn_mfma_f32_32x32x16_bf16(ah, bh[cb], acc[rb][cb], 0, 0, 0); acc[rb][cb] = __builtin_amdgcn_mfma_f32_32x32x16_bf16(ah, bl[cb], acc[rb][cb], 0, 0, 0); } } }
#pragma unroll
            for (int rb = 0; rb < 2; ++rb) { const int rbase = ksl * 128 + 64 * rh + 32 * rb;
#pragma unroll
                for (int cb = 0; cb < 2; ++cb) { const int c = 32 * cb + r32;
                    if (c < 36) {
#pragma unroll
                        for (int r = 0; r < 16; ++r) part[(rbase + (r & 3) + 8 * (r >> 2) + 4 * hh) * 37 + c] = acc[rb][cb][r]; } }
                const float sv = sq[rb] + __shfl_xor(sq[rb], 32); if (hh == 0) part[(rbase + r32) * 37 + 36] = sv; }
            __syncthreads();
            if (wave < 2) {
                const int row = 64 * wave + lane;
                float tot[5];
#pragma unroll
                for (int n = 0; n < 5; ++n) { const int nn = (n < 4) ? n : 36; float a = part[row * 37 + nn];
#pragma unroll
                    for (int w = 1; w < 4; ++w) a += part[(w * 128 + row) * 37 + nn];
                    tot[n] = a; }
                const float rs = 1.0f / sqrtf(tot[4] * (1.f / DM) + EPS); rsl[row] = rs;
                float gl[4];
#pragma unroll
                for (int q = 0; q < 4; ++q) gl[q] = rs * tot[q] + BP[b * 36 + q];
                int grp = 0; float gmax = gl[0];
#pragma unroll
                for (int q = 1; q < 4; ++q) if (gl[q] > gmax) { gmax = gl[q]; grp = q; }
                float gs = 0.f;
#pragma unroll
                for (int q = 0; q < 4; ++q) gs += expf(gl[q] - gmax);
                const float pgrp = 1.0f / gs;
                float el[8];
#pragma unroll
                for (int q = 0; q < 8; ++q) { const int nn = 4 + 8 * grp + q; float t = part[row * 37 + nn];
#pragma unroll
                    for (int w = 1; w < 4; ++w) t += part[(w * 128 + row) * 37 + nn];
                    el[q] = rs * t + BP[b * 36 + nn]; }
                int i0 = 0; float m0 = el[0];
#pragma unroll
                for (int q = 1; q < 8; ++q) if (el[q] > m0) { m0 = el[q]; i0 = q; }
                int i1 = -1; float m1 = -INFINITY;
#pragma unroll
                for (int q = 0; q < 8; ++q) if (q != i0 && el[q] > m1) { m1 = el[q]; i1 = q; }
                const float d = expf(m1 - m0), t0 = 1.0f / (1.0f + d), t1 = d * t0;
                const int e0 = 8 * grp + i0, e1 = 8 * grp + i1; const unsigned m = (unsigned)(row0 + row);
                LAS unsigned* hist = (LAS unsigned*)(L + 115200 + wave * 256);
                if (lane < 32) hist[lane] = 0u;
                asm volatile("s_waitcnt lgkmcnt(0)" ::: "memory");
                const unsigned r0 = __hip_atomic_fetch_add(hist + e0, 1u, __ATOMIC_RELAXED, __HIP_MEMORY_SCOPE_WORKGROUP);
                const unsigned r1 = __hip_atomic_fetch_add(hist + e1, 1u, __ATOMIC_RELAXED, __HIP_MEMORY_SCOPE_WORKGROUP);
                asm volatile("s_waitcnt lgkmcnt(0)" ::: "memory");
                if (lane < 32) { const unsigned c = hist[lane]; unsigned base = 0u; if (c) base = atomicAdd(ecnt_ + lane * 64, c); hist[32 + lane] = base; }
                asm volatile("s_waitcnt vmcnt(0) lgkmcnt(0)" ::: "memory");
                const unsigned p0 = hist[32 + e0] + r0, p1 = hist[32 + e1] + r1;
                list[(size_t)e0 * ECAP + p0] = 2u * m; lw[(size_t)e0 * ECAP + p0] = pgrp * t0;
                list[(size_t)e1 * ECAP + p1] = 2u * m + 1u; lw[(size_t)e1 * ECAP + p1] = pgrp * t1;
            }
            __syncthreads();
            const float* md = mod + b * 6144;
            f32x4 ga[2][2], shv[2][2];
#pragma unroll
            for (int j = 0; j < 2; ++j)
#pragma unroll
                for (int hq = 0; hq < 2; ++hq) { const int col = 512 * j + 8 * lane + 4 * hq; ga[j][hq] = *(const f32x4*)(g2 + col) * (*(const f32x4*)(md + 4096 + col) + 1.0f); shv[j][hq] = *(const f32x4*)(md + 3072 + col); }
#pragma unroll 1
            for (int i0 = 0; i0 < 16; i0 += 4) {
                u32x4 xw[4][2];
#pragma unroll
                for (int r = 0; r < 4; ++r) { const u32x4* xr = (const u32x4*)(X1B + (size_t)(row0 + wave * 16 + i0 + r) * DM) + lane;
#pragma unroll
                    for (int j = 0; j < 2; ++j) xw[r][j] = xr[64 * j]; }
#pragma unroll
                for (int r = 0; r < 4; ++r) { const float rs = rsl[wave * 16 + i0 + r]; u32x4* o8 = (u32x4*)(H2 + (size_t)(row0 + wave * 16 + i0 + r) * DM) + lane;
#pragma unroll
                    for (int j = 0; j < 2; ++j) { const u32x4 w = xw[r][j];
                        const f32x4 x0 = {bflo(w.x), bfhi(w.x), bflo(w.y), bfhi(w.y)}, x1 = {bflo(w.z), bfhi(w.z), bflo(w.w), bfhi(w.w)};
                        o8[64 * j] = pack8(x0 * rs * ga[j][0] + shv[j][0], x1 * rs * ga[j][1] + shv[j][1]); } }
            }
            __syncthreads();
        }
        for (;;) {
            if (tid0 == 0) MISC[102] = xb_add(ctl + CW_WQ, 1u);
            __syncthreads(); const unsigned tq = MISC[102];
            if (tq >= (unsigned)W13_TILES) { __syncthreads(); break; }
            { const int kind_ = (int)tq >> 10, r_ = (int)tq & 1023, e_ = r_ >> 5, q_ = r_ & 31; wg_tile((const float*)KIN(kind_ ? I_W3 : I_W1) + (size_t)e_ * DM * EFF, EFF, 64 * (q_ >> 1), 256 * (q_ & 1), (bf16_t*)(ws + WS_W13), DM, e_ * 1024 + 128 * kind_, 0, true, (LAS float*)L, wave, lane); } }
    }
    SEAM(8);

    if (IN(9) || IN(10)) {
        if (tid0 < 64) {
            const unsigned nt = (tid0 < NEXP) ? (__hip_atomic_load(ecnt + tid0 * 64, RLX_AGENT) + 255u) >> 8 : 0u; unsigned inc = nt;
#pragma unroll
            for (int o = 1; o < 32; o <<= 1) { const unsigned t = __shfl_up(inc, o); if ((tid0 & 63) >= o) inc += t; }
            if (tid0 < NEXP) MISC[16 + tid0] = inc - nt;
            if (tid0 == NEXP - 1) { MISC[16 + 32] = inc; MISC[16 + 33] = inc; } }
        __syncthreads();
    }
    const int moeU = (IN(9) || IN(10)) ? 4 * (int)MISC[16 + 33] : 0, moeR = moeU / G, moeRem = moeU % G; const bool moeSplit = (moeRem > 0) && (2 * moeRem <= G);
    const bool hxcd = (moeRem % 8) == 0; const int hu = hxcd ? (bx & 7) + 8 * ((bx >> 3) >> 1) : (bx >> 1), hh = hxcd ? ((bx >> 3) & 1) : (bx & 1);
    if (IN(9)) {
        const int tid = opq(tid0);
        OrderMoe S{MISC + 16, ecnt, G, bx, moeSplit ? moeR : moeR + 1};
        const unsigned* list = (const unsigned*)(ws + WS_LIST); LAS unsigned* tokl = (LAS unsigned*)(L + TOKL_OFF);
        { Unit u; for (int i = 0; i < MAXU && S.next(i, u); ++i) if (tid < 256) tokl[i * 256 + tid] = (tid < u.cnt) ? (list[(size_t)u.e * ECAP + u.aux * 256 + tid] >> 1) : 0u; }
        Unit uh; const bool half = moeSplit && (bx < 2 * moeRem) && S.at((long)moeR * G + hu, uh);
        if (half) { if (tid < 256) tokl[moeR * 256 + tid] = (tid < uh.cnt) ? (list[(size_t)uh.e * ECAP + uh.aux * 256 + tid] >> 1) : 0u; uh.roff = 128 * hh; uh.nai = 1; }
        __syncthreads();
        pg8::Gemm g{(const bf16_t*)(ws + WS_H2), (const bf16_t*)(ws + WS_W13), DM, DM};
        EpiMoe1 E{(bf16_t*)(ws + WS_HM)};
        pg8::gemm_phase<EpiMoe1, OrderMoe, true>(L, g, S, E, tokl);
        if (half) { OrderOne S1{uh}; pg8::gemm_phase<EpiMoe1, OrderOne, true, true>(L, g, S1, E, tokl + moeR * 256 + uh.roff); }
        { const int lane = tid & 63; unsigned nxt = 0u;
            if (tid0 == 0) nxt = xb_add(ctl + CW_W2Q, 1u);
            for (;;) {
                if (tid0 == 0) { MISC[102] = nxt; if (nxt < (unsigned)(NEXP * 32)) nxt = xb_add(ctl + CW_W2Q, 1u); }
                __syncthreads(); const unsigned it = MISC[102];
                if (it >= (unsigned)(NEXP * 32)) { __syncthreads(); break; }
                const int e = (int)it / 32, q = (int)it % 32;
                wg_tile((const float*)KIN(I_W2) + (size_t)e * EFF * DM, DM, 64 * (q >> 2), 256 * (q & 3), (bf16_t*)(ws + WS_W2), EFF, e * 1024, 0, false, (LAS float*)L, wave, lane); } }
    }
    SEAM(9);
    if (IN(10)) {
        OrderMoe S{MISC + 16, ecnt, G, bx, moeSplit ? moeR : moeR + 1};
        pg8::Gemm g{(const bf16_t*)(ws + WS_HM), (const bf16_t*)(ws + WS_W2), EFF, EFF};
        EpiMoe2 E{(const unsigned*)(ws + WS_LIST), (const float*)(ws + WS_LW), (bf16_t*)(ws + WS_Y)};
        pg8::gemm_phase<EpiMoe2, OrderMoe, false>(L, g, S, E, nullptr);
        Unit uh; if (moeSplit && (bx < 2 * moeRem) && S.at((long)moeR * G + hu, uh)) { uh.roff = 128 * hh; uh.nai = 1; uh.arow += uh.roff;
            OrderOne S1{uh}; pg8::gemm_phase<EpiMoe2, OrderOne, false, true>(L, g, S1, E, nullptr); }
    }
    SEAM(10);

    if (IN(11)) {
        const int tid = opq(tid0), lane = tid & 63; (void)tid;
        const bf16_t* Y = (const bf16_t*)(ws + WS_Y); const float* fg = (const float*)KIN(I_FG);
        for (int m = gw; m < NTOK; m += NGW) { const float* md = mod + (m / SEQ) * 6144 + 5120;
            const u32x2* xr = (const u32x2*)(ws + WS_X1B + (size_t)m * DM * 2) + lane; f32x4* xw = (f32x4*)(out + (size_t)m * DM) + lane; const u32x2* y0 = (const u32x2*)(Y + (size_t)(2 * m) * DM) + lane; const u32x2* y1 = (const u32x2*)(Y + (size_t)(2 * m + 1) * DM) + lane;
            f32x4 v[4]; float s = 0.f;
#pragma unroll
            for (int j = 0; j < 4; ++j) { const int col = 256 * j + 4 * lane; const u32x2 a = y0[64 * j], b = y1[64 * j]; const f32x4 g2 = *(const f32x4*)(md + col);
                const f32x4 ys = {bflo(a.x) + bflo(b.x), bfhi(a.x) + bfhi(b.x), bflo(a.y) + bflo(b.y), bfhi(a.y) + bfhi(b.y)};
                const u32x2 xq = xr[64 * j]; v[j] = (f32x4){bflo(xq.x), bfhi(xq.x), bflo(xq.y), bfhi(xq.y)} + g2 * ys; s += (v[j][0] * v[j][0] + v[j][1] * v[j][1]) + (v[j][2] * v[j][2] + v[j][3] * v[j][3]); }
            const float rs = 1.0f / sqrtf(wave_sum(s) * (1.f / DM) + EPS);
#pragma unroll
            for (int j = 0; j < 4; ++j) { const int col = 256 * j + 4 * lane; xw[64 * j] = v[j] * rs * *(const f32x4*)(fg + col); } }
    }
#undef IN
#undef SEAM
}

extern "C" void kernel_launch(void* const* d_in, const int* in_sizes, int n_in, void* d_out, int out_size, void* d_ws, size_t ws_size, hipStream_t stream) {
    static int grid = 0;
    if (grid == 0) {
        if (n_in != 27 || out_size != NTOK * DM || ws_size < WS_END) { fprintf(stderr, "kernel_launch: unexpected shapes (n_in %d, out %d, ws %zu)\n", n_in, out_size, ws_size); grid = -1; return; }
        int dev = 0, cus = 0;
        if (hipGetDevice(&dev) != hipSuccess || hipDeviceGetAttribute(&cus, hipDeviceAttributeMultiprocessorCount, dev) != hipSuccess) { grid = -1; return; }
        if (hipFuncSetAttribute((const void*)fwd_kernel, hipFuncAttributeMaxDynamicSharedMemorySize, LDS_BYTES) != hipSuccess) { fprintf(stderr, "kernel_launch: hipFuncSetAttribute failed\n"); grid = -1; return; }
        (void)hipGetLastError();
        grid = cus;
    }
    if (grid < 0) return;
    (void)hipMemsetAsync((char*)d_ws + WS_CTL, 0, CTL_ZERO_BYTES, stream);
    Args a{};
    for (int i = 0; i < 27; ++i) a.in[i] = d_in[i];
    a.out = (float*)d_out; a.ws = (unsigned char*)d_ws;
#if MK_ONE_LAUNCH
    a.ph_lo = 0; a.ph_hi = NPHASE;
    hipLaunchKernelGGL(fwd_kernel, dim3(grid), dim3(NWAVES * 64), LDS_BYTES, stream, a);
#else
    for (int p = 0; p < NPHASE; ++p) { a.ph_lo = p; a.ph_hi = p + 1; hipLaunchKernelGGL(fwd_kernel, dim3(grid), dim3(NWAVES * 64), LDS_BYTES, stream, a); }
#endif
}
```
